# Optimizing an MI355X kernel written in HIP

```python
import math
import jax, jax.numpy as jnp
from jax import lax
import numpy as np

D_MODEL = 1024
BATCH = 8
SEQ = 2048
DEPTH = 4
DEC_BATCH = 128
DEC_SEQ = 1
PAST_LEN = 16384
PAGE_SIZE = 128

N_MIXERS = 2
N_CHUNK_LAYERS = (DEPTH + N_MIXERS - 1) // N_MIXERS
N_DELTA_LAYERS = DEPTH // N_MIXERS
CHUNK = 128
D_A = 2 * D_MODEL
H_A = 8
HD_A = D_A // H_A
H_B = 8
DK = 128
DV = 128
KEY_DIM = H_B * DK
VAL_DIM = H_B * DV
QKV_DIM = 2 * KEY_DIM + VAL_DIM
B_IN_DIM = QKV_DIM + VAL_DIM + 2 * H_B
CONV_W = 4
DELTA_CHUNK = 64
D_FF = ((8 * D_MODEL + 3 * 256 - 1) // (3 * 256)) * 256
EPS = 1e-6

kernel_name = "hybrid_chunkmlp_gdn_decode_step"


def rmsnorm(x, g):
    xf = x.astype(jnp.float32)
    xf = xf * lax.rsqrt(jnp.mean(xf * xf, axis=-1, keepdims=True) + EPS)
    return (xf * g.astype(jnp.float32)).astype(x.dtype)


def l2norm(x):
    xf = x.astype(jnp.float32)
    return xf * lax.rsqrt(jnp.sum(xf * xf, axis=-1, keepdims=True) + EPS)


def swiglu_ffn(h, w_in, w_out):
    gate, up = jnp.split(h @ w_in, 2, axis=-1)
    return (jax.nn.silu(gate) * up) @ w_out


def chunk_spatial_mix(v, w_s, b_s):
    B, T, _ = v.shape
    nc = -(-T // CHUNK)
    pad = nc * CHUNK - T
    vp = jnp.pad(v, ((0, 0), (0, pad), (0, 0))).reshape(B, nc, CHUNK, H_A, HD_A)
    causal = jnp.tril(jnp.ones((CHUNK, CHUNK), dtype=bool))
    w = jnp.where(causal, w_s, jnp.zeros_like(w_s))
    out = jnp.einsum('gts,bcsgd->bctgd', w, vp) + b_s.T[None, None, :, :, None]
    return out.reshape(B, nc * CHUNK, D_A)[:, :T]


def chunk_mlp_mixer(h, w_in, g_v, w_s, b_s, w_out):
    u, v = jnp.split(jax.nn.gelu(h @ w_in), 2, axis=-1)
    v = rmsnorm(v, g_v)
    return (u * chunk_spatial_mix(v, w_s, b_s)) @ w_out, v


def short_conv(buf, x_new, w):
    full = jnp.concatenate([buf.astype(x_new.dtype), x_new], axis=1)
    T = x_new.shape[1]
    y = full[:, 0:T] * w[0]
    for j in range(1, CONV_W):
        y = y + full[:, j:j + T] * w[j]
    return jax.nn.silu(y), full[:, -(CONV_W - 1):]


def delta_recurrent(q, k, v, g, beta, s0):
    def step(S, inp):
        q_t, k_t, v_t, g_t, b_t = inp
        S = S * jnp.exp(g_t)[..., None, None]
        pred = jnp.einsum('bhkv,bhk->bhv', S, k_t)
        S = S + jnp.einsum('bhk,bhv->bhkv', k_t, b_t[..., None] * (v_t - pred))
        return S, jnp.einsum('bhkv,bhk->bhv', S, q_t)
    xs = (jnp.moveaxis(q, 1, 0), jnp.moveaxis(k, 1, 0), jnp.moveaxis(v, 1, 0),
          jnp.moveaxis(g, 1, 0), jnp.moveaxis(beta, 1, 0))
    S, o = lax.scan(step, s0, xs)
    return jnp.moveaxis(o, 0, 1), S


def delta_chunked(q, k, v, g, beta, s0):
    B, T, H, _ = q.shape
    C = DELTA_CHUNK
    nc = T // C

    def blk(a):
        a = a.reshape(B, nc, C, H, *a.shape[3:])
        return jnp.moveaxis(jnp.moveaxis(a, 1, 0), 2, 3)

    q, k, v, g, beta = blk(q), blk(k), blk(v), blk(g), blk(beta)
    gc = jnp.cumsum(g, axis=-1)
    idx = jnp.arange(C)
    incl = idx[:, None] >= idx[None, :]
    strict = idx[:, None] > idx[None, :]
    diff = gc[..., :, None] - gc[..., None, :]
    decay = jnp.where(incl, jnp.exp(jnp.where(incl, diff, 0.0)), 0.0)
    kb = k * beta[..., None]
    L = jnp.where(strict, jnp.einsum('...id,...jd->...ij', kb, k) * decay, 0.0)
    eye = jnp.eye(C, dtype=jnp.float32)
    Tm = lax.linalg.triangular_solve(eye + L, jnp.broadcast_to(eye, L.shape),
                                     left_side=True, lower=True)
    u = Tm @ (v * beta[..., None])
    w = Tm @ (kb * jnp.exp(gc)[..., None])
    A = jnp.einsum('...id,...jd->...ij', q, k) * decay

    def step(S, inp):
        q_c, k_c, u_c, w_c, gc_c, A_c = inp
        v_new = u_c - jnp.einsum('bhck,bhkv->bhcv', w_c, S)
        o = (jnp.einsum('bhck,bhkv->bhcv', q_c * jnp.exp(gc_c)[..., None], S)
             + jnp.einsum('bhij,bhjv->bhiv', A_c, v_new))
        g_last = gc_c[..., -1:]
        S = (S * jnp.exp(g_last)[..., None]
             + jnp.einsum('bhck,bhcv->bhkv', k_c * jnp.exp(g_last - gc_c)[..., None], v_new))
        return S, o

    S, o = lax.scan(step, s0, (q, k, u, w, gc, A))
    o = jnp.moveaxis(jnp.moveaxis(o, 3, 2), 0, 1).reshape(B, T, H, -1)
    return o, S


def delta_mixer(h, conv_buf, s0, w_in, w_conv, a_log, dt_bias, g_o, w_out, chunked):
    B, T, _ = h.shape
    proj = h @ w_in
    qkv_raw, gate, ba = jnp.split(proj, [QKV_DIM, QKV_DIM + VAL_DIM], axis=-1)
    qkv, new_buf = short_conv(conv_buf, qkv_raw, w_conv)
    q, k, v = jnp.split(qkv, [KEY_DIM, 2 * KEY_DIM], axis=-1)
    q = l2norm(q.reshape(B, T, H_B, DK)) * (DK ** -0.5)
    k = l2norm(k.reshape(B, T, H_B, DK))
    v = v.reshape(B, T, H_B, DV).astype(jnp.float32)
    b_raw, a_raw = jnp.split(ba.astype(jnp.float32), 2, axis=-1)
    beta = jax.nn.sigmoid(b_raw)
    g = -jnp.exp(a_log.astype(jnp.float32)) * jax.nn.softplus(a_raw + dt_bias.astype(jnp.float32))
    if chunked:
        o, s_new = delta_chunked(q, k, v, g, beta, s0.astype(jnp.float32))
    else:
        o, s_new = delta_recurrent(q, k, v, g, beta, s0.astype(jnp.float32))
    o = rmsnorm(o, g_o) * jax.nn.silu(gate.reshape(B, T, H_B, DV).astype(jnp.float32))
    return o.reshape(B, T, VAL_DIM).astype(h.dtype) @ w_out, new_buf, s_new


def run_trunk(x, conv_in, delta_in, p, chunked):
    v_rows, conv_out, delta_out = [], [], []
    for i in range(DEPTH):
        h = rmsnorm(x, p['norm_mix'][i])
        j = i // N_MIXERS
        if i % N_MIXERS == 0:
            y, v = chunk_mlp_mixer(h, p['a_w_in'][j], p['a_v_norm'][j], p['a_w_spatial'][j],
                                   p['a_b_spatial'][j], p['a_w_out'][j])
            v_rows.append(v)
        else:
            y, cb, s = delta_mixer(h, conv_in[j], delta_in[j], p['b_w_in'][j], p['b_w_conv'][j],
                                   p['b_a_log'][j], p['b_dt_bias'][j], p['b_o_norm'][j],
                                   p['b_w_out'][j], chunked)
            conv_out.append(cb)
            delta_out.append(s)
        x = x + y
        x = x + swiglu_ffn(rmsnorm(x, p['norm_ffn'][i]), p['ffn_w_in'][i], p['ffn_w_out'][i])
    return rmsnorm(x, p['norm_final']), v_rows, conv_out, delta_out


def setup_inputs(seed: int = 0) -> dict:
    key = jax.random.key(seed)
    ks = jax.random.split(key, 24)
    f32 = jnp.float32
    NA, NB = N_CHUNK_LAYERS, N_DELTA_LAYERS

    def nrm(k, shape, scale):
        return jax.random.normal(k, shape, f32) * scale

    def gain(k, shape):
        return 1.0 + 0.05 * jax.random.normal(k, shape, f32)

    dt = jnp.exp(jax.random.uniform(ks[16], (NB, H_B), f32, math.log(1e-3), math.log(1e-1)))
    return {
        'x_prompt': nrm(ks[0], (BATCH, SEQ, D_MODEL), 1.0),
        'x_sample': nrm(ks[1], (DEC_BATCH, DEC_SEQ, D_MODEL), 1.0),
        'state_delta': nrm(ks[2], (NB, DEC_BATCH, H_B, DK, DV), 0.1),
        'state_conv': nrm(ks[3], (NB, DEC_BATCH, CONV_W - 1, QKV_DIM), 1.0),
        'norm_mix': gain(ks[4], (DEPTH, D_MODEL)),
        'norm_ffn': gain(ks[5], (DEPTH, D_MODEL)),
        'norm_final': gain(ks[6], (D_MODEL,)),
        'a_w_in': nrm(ks[7], (NA, D_MODEL, 2 * D_A), D_MODEL ** -0.5),
        'a_v_norm': gain(ks[8], (NA, D_A)),
        'a_w_spatial': nrm(ks[9], (NA, H_A, CHUNK, CHUNK), 0.5 * CHUNK ** -0.5),
        'a_b_spatial': 1.0 + 0.1 * jax.random.normal(ks[10], (NA, H_A, CHUNK), f32),
        'a_w_out': nrm(ks[11], (NA, D_A, D_MODEL), 0.5 * D_A ** -0.5),
        'b_w_in': nrm(ks[12], (NB, D_MODEL, B_IN_DIM), D_MODEL ** -0.5),
        'b_w_conv': nrm(ks[13], (NB, CONV_W, QKV_DIM), CONV_W ** -0.5),
        'b_a_log': jnp.log(jax.random.uniform(ks[14], (NB, H_B), f32, 1.0, 16.0)),
        'b_dt_bias': dt + jnp.log(-jnp.expm1(-dt)),
        'b_o_norm': gain(ks[15], (NB, DV)),
        'b_w_out': nrm(ks[17], (NB, VAL_DIM, D_MODEL), 0.5 * VAL_DIM ** -0.5),
        'ffn_w_in': nrm(ks[18], (DEPTH, D_MODEL, 2 * D_FF), D_MODEL ** -0.5),
        'ffn_w_out': nrm(ks[19], (DEPTH, D_FF, D_MODEL), 0.5 * D_FF ** -0.5),
    }


def reference(x_prompt, x_sample, state_delta, state_conv, norm_mix, norm_ffn, norm_final,
              a_w_in, a_v_norm, a_w_spatial, a_b_spatial, a_w_out,
              b_w_in, b_w_conv, b_a_log, b_dt_bias, b_o_norm, b_w_out,
              ffn_w_in, ffn_w_out):
    p = {'norm_mix': norm_mix, 'norm_ffn': norm_ffn, 'norm_final': norm_final,
         'a_w_in': a_w_in, 'a_v_norm': a_v_norm, 'a_w_spatial': a_w_spatial,
         'a_b_spatial': a_b_spatial, 'a_w_out': a_w_out,
         'b_w_in': b_w_in, 'b_w_conv': b_w_conv, 'b_a_log': b_a_log, 'b_dt_bias': b_dt_bias,
         'b_o_norm': b_o_norm, 'b_w_out': b_w_out,
         'ffn_w_in': ffn_w_in, 'ffn_w_out': ffn_w_out}
    conv0 = jnp.zeros((N_DELTA_LAYERS, BATCH, CONV_W - 1, QKV_DIM), x_prompt.dtype)
    delta0 = jnp.zeros((N_DELTA_LAYERS, BATCH, H_B, DK, DV), jnp.float32)
    y_prompt, _, conv_p, delta_p = run_trunk(x_prompt, conv0, delta0, p, True)
    y_sample, v_s, conv_s, delta_s = run_trunk(x_sample, state_conv, state_delta, p, False)
    new_delta_prompt = jnp.stack(delta_p)
    new_conv_prompt = jnp.stack(conv_p)
    new_delta_sample = jnp.stack(delta_s)
    new_conv_sample = jnp.stack(conv_s)
    new_chunk_v_sample = jnp.stack(v_s)
    return (y_prompt, y_sample, new_delta_prompt, new_conv_prompt,
            new_delta_sample, new_conv_sample, new_chunk_v_sample)
```

```cpp
#include <hip/hip_runtime.h>
#include <hip/hip_cooperative_groups.h>
#include <cstdio>
#include <cstdint>
namespace cg = cooperative_groups;

#ifndef MULTI_LAUNCH
#define MULTI_LAUNCH 0
#endif

#define LAS __attribute__((address_space(3)))
typedef unsigned short bf16_t;
typedef short bf16x8 __attribute__((ext_vector_type(8)));
typedef float f32x4 __attribute__((ext_vector_type(4)));
typedef float f32x2 __attribute__((ext_vector_type(2)));
typedef unsigned u32x4 __attribute__((ext_vector_type(4)));
typedef unsigned u32x2 __attribute__((ext_vector_type(2)));

constexpr int D = 1024, MP = 16384, MS = 128, MT = MP + MS;
constexpr int DA = 2048, DFF = 2816, NFIN = 5632, QKV = 3072, BIN = 4112;
constexpr float EPS = 1e-6f;
constexpr int NPHASE = 28;

constexpr size_t al(size_t x) { return (x + 255) & ~(size_t)255; }
constexpr size_t W_AIN = 0;
constexpr size_t W_AOUT = W_AIN + 2ull * 4096 * 1024 * 2;
constexpr size_t W_BIN = W_AOUT + 2ull * 1024 * 2048 * 2;
constexpr size_t W_BA = W_BIN + 2ull * 4096 * 1024 * 2;
constexpr size_t W_BOUT = W_BA + 2ull * 16 * 1024 * 2;
constexpr size_t W_FIN = W_BOUT + 2ull * 1024 * 1024 * 2;
constexpr size_t W_FOUT = W_FIN + 4ull * 5632 * 1024 * 2;
constexpr size_t A_XRES = W_FOUT + 4ull * 1024 * 2816 * 2;
constexpr size_t A_XB = A_XRES;
constexpr size_t A_SSQ = A_XB + (size_t)MT * 1024 * 2;
constexpr size_t A_BA = al(A_SSQ + 9ull * MT * 32 * 4);
constexpr size_t A_BE = A_BA + (size_t)MT * 16 * 4;
constexpr size_t A_VS = A_BE + (size_t)MT * 16 * 4;
constexpr size_t A_VSQ = al(A_VS + 128ull * 2048 * 4);
constexpr size_t A_BAR = al(A_VSQ + (size_t)MP * 32 * 4);
constexpr size_t A_R = al(A_BAR + 16384);
constexpr size_t R_U = A_R;
constexpr size_t R_VT = al(R_U + (size_t)MT * 2048 * 2);
constexpr size_t R_P = al(R_VT + 2048ull * 16384 * 2);
constexpr size_t R_AEND = R_P + (size_t)MT * 2048 * 2;
constexpr size_t R_ACT = A_R;
constexpr size_t R_PROJ = A_R;
constexpr size_t R_QN = al(R_PROJ + (size_t)MT * 4096 * 2);
constexpr size_t R_KN = R_QN + (size_t)MT * 1024 * 2;
constexpr size_t R_VV = R_KN + (size_t)MT * 1024 * 2;
constexpr size_t R_OB = R_VV + (size_t)MT * 1024 * 2;
constexpr size_t R_OG = R_OB + (size_t)MP * 1024 * 2;
constexpr size_t R_BEND = R_OG + (size_t)MT * 1024 * 2;
constexpr size_t WS_END = R_AEND > R_BEND ? R_AEND : R_BEND;

constexpr size_t O_YP = 0, O_YS = 16777216, O_DP = O_YS + 131072, O_CP = O_DP + 2097152, O_DS = O_CP + 147456, O_CS = O_DS + 33554432, O_CV = O_CS + 2359296;

struct Params { const float* in[20]; float* out; unsigned char* ws; int ph_lo, ph_hi; };

typedef __bf16 bf16x2_t __attribute__((ext_vector_type(2)));
__device__ __forceinline__ unsigned pk_bf16(float lo, float hi) { const bf16x2_t r = __builtin_convertvector((f32x2){lo, hi}, bf16x2_t); return __builtin_bit_cast(unsigned, r); }
__device__ __forceinline__ float bf_lo(unsigned w) { return __uint_as_float(w << 16); }
__device__ __forceinline__ float bf_hi(unsigned w) { return __uint_as_float(w & 0xffff0000u); }
__device__ __forceinline__ float gelu_t(float x) { const float y = 1.5957691216057308f * (x + 0.044715f * x * x * x); return x * __builtin_amdgcn_rcpf(1.f + __expf(-y)); }
__device__ __forceinline__ float silu_f(float x) { return x * __builtin_amdgcn_rcpf(1.f + __expf(-x)); }
__device__ __forceinline__ int opaque_tid() { int t = threadIdx.x; asm volatile("" : "+v"(t)); return t; }
__device__ __forceinline__ float wave_sum(float v) {
#pragma unroll
    for (int o = 1; o < 64; o <<= 1) v += __shfl_xor(v, o);
    return v;
}
__device__ __forceinline__ float sum16(float v) {
#pragma unroll
    for (int o = 1; o < 16; o <<= 1) v += __shfl_xor(v, o);
    return v;
}
__device__ __forceinline__ float dpp_sum16(float x) {
    x += __int_as_float(__builtin_amdgcn_update_dpp(0, __float_as_int(x), 0xB1, 0xF, 0xF, false));
    x += __int_as_float(__builtin_amdgcn_update_dpp(0, __float_as_int(x), 0x4E, 0xF, 0xF, false));
    x += __int_as_float(__builtin_amdgcn_update_dpp(0, __float_as_int(x), 0x141, 0xF, 0xF, false));
    x += __int_as_float(__builtin_amdgcn_update_dpp(0, __float_as_int(x), 0x140, 0xF, 0xF, false));
    return x;
}

namespace pg8 {
constexpr int BM = 256, BK = 64, HALF = 128, HTB = HALF * BK * 2, STAGE_BYTES = 8 * HTB, NXCD = 8, WGM = 8;
__host__ __device__ __forceinline__ int lds_byte(int r, int c) { const int st = (r >> 4) * 2 + (c >> 5), rr = r & 15, cc = c & 31, ob = rr * 64 + cc * 2; return st * 1024 + (ob ^ (((ob >> 9) & 1) << 5)); }
__host__ __device__ __forceinline__ void stage_rc(int b, int& R, int& C) { const int st = b / 1024, sb = b % 1024, swz = sb ^ (((sb >> 9) & 1) << 5); R = (st >> 1) * 16 + swz / 64; C = (st & 1) * 32 + (swz % 64) / 2; }
__host__ __device__ __forceinline__ int perm32(int rho) { const int n = rho >> 4, i = rho & 15; return 8 * (i >> 2) + 4 * n + (i & 3); }
struct Unit { int pm, pn; };
struct Gemm { const bf16_t* A; const bf16_t* Bt; int M, N, K; };
struct StaticOrder {
    int nM, nN, nwg, G, c;
    __host__ __device__ void init(int M, int N, int G_, int c_) { nM = M / BM; nN = N / BM; nwg = nM * nN; G = G_; c = c_; }
    __host__ __device__ bool next(int i, Unit& u) const {
        const long L = (long)i * G + c; if (L >= nwg) return false;
        int wgid = (int)L; { const int q = nwg / NXCD, r = nwg % NXCD, xcd = wgid % NXCD, off = wgid / NXCD; wgid = (xcd < r ? xcd * (q + 1) : r * (q + 1) + (xcd - r) * q) + off; }
        const int nig = WGM * nN, gid = wgid / nig, fm = gid * WGM, gsz = (nM - fm) < WGM ? (nM - fm) : WGM;
        u.pm = fm + ((wgid % nig) % gsz); u.pn = (wgid % nig) / gsz; return true;
    }
};
template <class Epi, bool SWAP>
__device__ __forceinline__ void gemm_phase(LAS unsigned char* lds, const Gemm g, const StaticOrder& S, const Epi& E) {
    const int tid = opaque_tid(), wid = __builtin_amdgcn_readfirstlane(tid >> 6), lane = tid & 63, wr = wid >> 2, wc = wid & 3, fr = lane & 15, fq = lane >> 4;
    int K = g.K; asm volatile("" : "+s"(K)); const int nt = K / BK;
    unsigned voffA[2], voffB[2];
#pragma unroll
    for (int i = 0; i < 2; ++i) { int R, C; stage_rc(tid * 16 + i * 8192, R, C); const int Rb = Epi::PERM ? ((R & ~31) + perm32(R & 31)) : R;
        voffA[i] = (unsigned)(R * K + C) * 2u; voffB[i] = (unsigned)(Rb * K + C) * 2u; }
    const size_t kstep = (size_t)(BK * 2);
    const size_t hstep = (size_t)HALF * K * 2;
    const size_t tstep = 2 * hstep;
    const unsigned ldsw = (unsigned)wid * 1024u;
    const int aoff = lds_byte(wr * 64 + fr, fq * 8), boff = lds_byte(wc * 32 + fr, fq * 8);
#define PG8_SA(b, h) (((b) * 2 + (h)) * HTB)
#define PG8_SB(b, h) ((4 + (b) * 2 + (h)) * HTB)
#define PG8_STAGE(bufoff, gbase, voff) do { _Pragma("unroll") for (int _i = 0; _i < 2; ++_i) \
        __builtin_amdgcn_global_load_lds((const unsigned*)((const char*)(gbase) + (voff)[_i]), (LAS unsigned*)(lds + (bufoff) + ldsw + _i * 8192), 16, 0, 0); } while (0)
#define PG8_LDA(dst, b, h) do { _Pragma("unroll") for (int m = 0; m < 4; ++m) _Pragma("unroll") for (int k = 0; k < 2; ++k) dst[m][k] = *(const LAS bf16x8*)(lds + PG8_SA(b, h) + aoff + m * 2048 + k * 1024); } while (0)
#define PG8_LDB(dst, b, h) do { _Pragma("unroll") for (int n = 0; n < 2; ++n) _Pragma("unroll") for (int k = 0; k < 2; ++k) dst[n][k] = *(const LAS bf16x8*)(lds + PG8_SB(b, h) + boff + n * 2048 + k * 1024); } while (0)
#define PG8_MMA(ai, bj, At, Bt) do { __builtin_amdgcn_s_setprio(1); _Pragma("unroll") for (int m = 0; m < 4; ++m) _Pragma("unroll") for (int n = 0; n < 2; ++n) _Pragma("unroll") for (int k = 0; k < 2; ++k) \
        acc[ai][bj][m][n] = SWAP ? __builtin_amdgcn_mfma_f32_16x16x32_bf16(At[m][k], Bt[n][k], acc[ai][bj][m][n], 0, 0, 0) : __builtin_amdgcn_mfma_f32_16x16x32_bf16(Bt[n][k], At[m][k], acc[ai][bj][m][n], 0, 0, 0); __builtin_amdgcn_s_setprio(0); } while (0)
#define PG8_WAIT_V(n) asm volatile("s_waitcnt vmcnt(" #n ")" ::: "memory")
#define PG8_WAIT_L(n) asm volatile("s_waitcnt lgkmcnt(" #n ")" ::: "memory")
#define PG8_BAR __builtin_amdgcn_s_barrier()
#define PG8_SCHED __builtin_amdgcn_sched_barrier(0)
    Unit cur, nxt; int ui = 0;
    if (!S.next(0, cur)) return;
    f32x4 acc[2][2][4][2];
#pragma unroll
    for (int a = 0; a < 2; ++a)
#pragma unroll
        for (int b = 0; b < 2; ++b)
#pragma unroll
            for (int m = 0; m < 4; ++m)
#pragma unroll
                for (int n = 0; n < 2; ++n) acc[a][b][m][n] = (f32x4){0.f, 0.f, 0.f, 0.f};
    bf16x8 At[4][2], B0[2][2], B1[2][2];
    const char* cA = (const char*)g.A + (size_t)cur.pm * tstep; const char* cB = (const char*)g.Bt + (size_t)cur.pn * tstep;
    PG8_STAGE(PG8_SB(0, 0), cB, voffB); PG8_STAGE(PG8_SA(0, 0), cA, voffA); PG8_STAGE(PG8_SB(0, 1), cB + hstep, voffB); PG8_STAGE(PG8_SA(0, 1), cA + hstep, voffA);
    if (wr == 1) PG8_BAR;
    PG8_WAIT_V(4); PG8_BAR;
    PG8_STAGE(PG8_SB(1, 0), cB + kstep, voffB); PG8_STAGE(PG8_SA(1, 0), cA + kstep, voffA); PG8_STAGE(PG8_SB(1, 1), cB + hstep + kstep, voffB);
    PG8_WAIT_V(6); PG8_BAR;
    for (;;) {
        const bool has_next = S.next(ui + 1, nxt);
        const char* nA = has_next ? (const char*)g.A + (size_t)nxt.pm * tstep : cA; const char* nB = has_next ? (const char*)g.Bt + (size_t)nxt.pn * tstep : cB;
        for (int t = 0; t < nt; t += 2) {
            const bool last = (t == nt - 2);
            const char* a1 = cA + (size_t)(t + 1) * kstep;
            const char* a2 = last ? nA : cA + (size_t)(t + 2) * kstep; const char* b2 = last ? nB : cB + (size_t)(t + 2) * kstep;
            const char* a3 = a2 + kstep; const char* b3 = b2 + kstep;
            PG8_LDB(B0, 0, 0); PG8_SCHED; PG8_LDA(At, 0, 0); PG8_STAGE(PG8_SA(1, 1), a1 + hstep, voffA);
            PG8_WAIT_L(8); PG8_BAR; PG8_WAIT_L(0); PG8_MMA(0, 0, At, B0); PG8_BAR; PG8_SCHED;
            PG8_LDB(B1, 0, 1); PG8_STAGE(PG8_SB(0, 0), b2, voffB);
            PG8_BAR; PG8_WAIT_L(0); PG8_MMA(0, 1, At, B1); PG8_BAR;
            PG8_LDA(At, 0, 1); PG8_STAGE(PG8_SA(0, 0), a2, voffA);
            PG8_BAR; PG8_WAIT_L(0); PG8_MMA(1, 0, At, B0); PG8_BAR; PG8_SCHED;
            PG8_STAGE(PG8_SB(0, 1), b2 + hstep, voffB);
            PG8_WAIT_V(6); PG8_BAR; PG8_MMA(1, 1, At, B1); PG8_BAR;
            PG8_LDB(B0, 1, 0); PG8_SCHED; PG8_LDA(At, 1, 0); PG8_STAGE(PG8_SA(0, 1), a2 + hstep, voffA);
            PG8_WAIT_L(8); PG8_BAR; PG8_WAIT_L(0); PG8_MMA(0, 0, At, B0); PG8_BAR; PG8_SCHED;
            PG8_LDB(B1, 1, 1); PG8_STAGE(PG8_SB(1, 0), b3, voffB);
            PG8_BAR; PG8_WAIT_L(0); PG8_MMA(0, 1, At, B1); PG8_BAR;
            PG8_LDA(At, 1, 1); PG8_STAGE(PG8_SA(1, 0), a3, voffA);
            PG8_BAR; PG8_WAIT_L(0); PG8_MMA(1, 0, At, B0); PG8_BAR; PG8_SCHED;
            PG8_STAGE(PG8_SB(1, 1), b3 + hstep, voffB);
            PG8_WAIT_V(6); PG8_BAR; PG8_MMA(1, 1, At, B1); PG8_BAR;
        }
        E(acc, cur, ui, wr, wc, fr, fq);
        if (!has_next) break;
#pragma unroll
        for (int a = 0; a < 2; ++a)
#pragma unroll
            for (int b = 0; b < 2; ++b)
#pragma unroll
                for (int m = 0; m < 4; ++m)
#pragma unroll
                    for (int n = 0; n < 2; ++n) acc[a][b][m][n] = (f32x4){0.f, 0.f, 0.f, 0.f};
        cur = nxt; cA = nA; cB = nB; ++ui;
    }
    PG8_WAIT_V(0);
    if (wr == 0) PG8_BAR;
    PG8_BAR;
#undef PG8_SA
#undef PG8_SB
#undef PG8_STAGE
#undef PG8_LDA
#undef PG8_LDB
#undef PG8_MMA
#undef PG8_WAIT_V
#undef PG8_WAIT_L
#undef PG8_BAR
#undef PG8_SCHED
}
}
using pg8::Unit;

__device__ __forceinline__ float rs_of(const float* ssq, int row) {
    const f32x4* q = (const f32x4*)(ssq + (size_t)row * 32); f32x4 a = q[0];
#pragma unroll
    for (int i = 1; i < 8; ++i) a += q[i];
    return rsqrtf(((a[0] + a[1]) + (a[2] + a[3])) * (1.f / 1024.f) + EPS);
}
__device__ __forceinline__ void load_rs(float* rsb, const float* ssq, const pg8::StaticOrder& S) {
    const int tid = opaque_tid(); f32x4 v[6][4];
#pragma unroll
    for (int ui = 0; ui < 6; ++ui) { Unit u; const bool ok = S.next(ui, u); const f32x4* q = (const f32x4*)(ssq + ((size_t)(ok ? u.pm : 0) * 256 + (tid >> 1)) * 32 + (tid & 1) * 16);
#pragma unroll
        for (int i = 0; i < 4; ++i) v[ui][i] = q[i]; }
#pragma unroll
    for (int ui = 0; ui < 6; ++ui) { const f32x4 a = (v[ui][0] + v[ui][1]) + (v[ui][2] + v[ui][3]); float t = (a[0] + a[1]) + (a[2] + a[3]); t += __shfl_xor(t, 1);
        if ((tid & 1) == 0) rsb[ui * 256 + (tid >> 1)] = rsqrtf(t * (1.f / 1024.f) + EPS); }
    __syncthreads();
}

struct EpiGeluU {
    static constexpr bool PERM = true;
    bf16_t* U; const float* rsb;
    __device__ __forceinline__ void operator()(const f32x4 (&acc)[2][2][4][2], const Unit& u, int ui, int wr, int wc, int fr, int fq) const {
        float rsv[2][4];
#pragma unroll
        for (int ai = 0; ai < 2; ++ai)
#pragma unroll
            for (int m = 0; m < 4; ++m) rsv[ai][m] = rsb[ui * 256 + ai * 128 + wr * 64 + m * 16 + fr];
#pragma unroll
        for (int ai = 0; ai < 2; ++ai)
#pragma unroll
            for (int m = 0; m < 4; ++m) {
                const int row = u.pm * 256 + ai * 128 + wr * 64 + m * 16 + fr; const float rs = rsv[ai][m];
#pragma unroll
                for (int bj = 0; bj < 2; ++bj) {
                    const int col = u.pn * 256 + bj * 128 + wc * 32 + 8 * fq;
                    const f32x4 a = acc[ai][bj][m][0] * rs, b = acc[ai][bj][m][1] * rs;
                    u32x4 w; w.x = pk_bf16(gelu_t(a[0]), gelu_t(a[1])); w.y = pk_bf16(gelu_t(a[2]), gelu_t(a[3])); w.z = pk_bf16(gelu_t(b[0]), gelu_t(b[1])); w.w = pk_bf16(gelu_t(b[2]), gelu_t(b[3]));
                    *(u32x4*)(U + (size_t)row * DA + col) = w; } }
    }
};
struct EpiGeluVT {
    static constexpr bool PERM = false;
    bf16_t* VT; const float* rsb; float* vsq;
    __device__ __forceinline__ void operator()(const f32x4 (&acc)[2][2][4][2], const Unit& u, int ui, int wr, int wc, int fr, int fq) const {
        f32x4 sv[2][4];
#pragma unroll
        for (int ai = 0; ai < 2; ++ai)
#pragma unroll
            for (int m = 0; m < 4; ++m) sv[ai][m] = *(const f32x4*)(rsb + ui * 256 + ai * 128 + wr * 64 + m * 16 + 4 * fq);
#pragma unroll
        for (int ai = 0; ai < 2; ++ai)
#pragma unroll
            for (int m = 0; m < 4; ++m) {
                const int row0 = u.pm * 256 + ai * 128 + wr * 64 + m * 16 + 4 * fq;
                const f32x4 r4 = sv[ai][m]; f32x4 ss = (f32x4){0.f, 0.f, 0.f, 0.f};
#pragma unroll
                for (int bj = 0; bj < 2; ++bj)
#pragma unroll
                    for (int n = 0; n < 2; ++n) {
                        const int col = u.pn * 256 + bj * 128 + wc * 32 + n * 16 + fr;
                        const f32x4 a = acc[ai][bj][m][n] * r4;
                        const f32x4 gq = (f32x4){gelu_t(a[0]), gelu_t(a[1]), gelu_t(a[2]), gelu_t(a[3])}; ss += gq * gq;
                        u32x2 w; w.x = pk_bf16(gq[0], gq[1]); w.y = pk_bf16(gq[2], gq[3]);
                        *(u32x2*)(VT + (size_t)col * MP + row0) = w; }
                ss[0] = dpp_sum16(ss[0]); ss[1] = dpp_sum16(ss[1]); ss[2] = dpp_sum16(ss[2]); ss[3] = dpp_sum16(ss[3]);
                if (fr == 0) {
#pragma unroll
                    for (int r = 0; r < 4; ++r) vsq[(size_t)(row0 + r) * 32 + u.pn * 4 + wc] = ss[r]; } }
    }
};
struct EpiGeluS {
    bf16_t* U; float* VS; const float* ssq;
    __device__ __forceinline__ int brow(int tau, int n) const { return 32 * tau + 16 * n; }
    __device__ __forceinline__ void sk(int row, int tau, int fq, const f32x4 v0, const f32x4 v1) const {
        const float rs = rs_of(ssq, row);
#pragma unroll
        for (int n = 0; n < 2; ++n) {
            const f32x4 a = (n ? v1 : v0) * rs; const int c = 32 * tau + 16 * n + 4 * fq;
            f32x4 gq; gq[0] = gelu_t(a[0]); gq[1] = gelu_t(a[1]); gq[2] = gelu_t(a[2]); gq[3] = gelu_t(a[3]);
            if (c < DA) { u32x2 w; w.x = pk_bf16(gq[0], gq[1]); w.y = pk_bf16(gq[2], gq[3]); *(u32x2*)(U + (size_t)row * DA + c) = w; }
            else *(f32x4*)(VS + (size_t)(row - MP) * DA + (c - DA)) = gq; }
    }
};
struct EpiSwiglu {
    static constexpr bool PERM = true;
    bf16_t* ACT; const float* ssq; const float* rsb;
    __device__ __forceinline__ void operator()(const f32x4 (&acc)[2][2][4][2], const Unit& u, int ui, int wr, int wc, int fr, int fq) const {
        float rsv[2][4];
#pragma unroll
        for (int ai = 0; ai < 2; ++ai)
#pragma unroll
            for (int m = 0; m < 4; ++m) rsv[ai][m] = rsb[ui * 256 + ai * 128 + wr * 64 + m * 16 + fr];
#pragma unroll
        for (int ai = 0; ai < 2; ++ai)
#pragma unroll
            for (int m = 0; m < 4; ++m) {
                const int row = u.pm * 256 + ai * 128 + wr * 64 + m * 16 + fr; const float rs = rsv[ai][m];
                const int f = u.pn * 128 + wc * 32 + 8 * fq;
                const f32x4 g0 = acc[ai][0][m][0] * rs, g1 = acc[ai][0][m][1] * rs, u0 = acc[ai][1][m][0] * rs, u1 = acc[ai][1][m][1] * rs;
                u32x4 w; w.x = pk_bf16(silu_f(g0[0]) * u0[0], silu_f(g0[1]) * u0[1]); w.y = pk_bf16(silu_f(g0[2]) * u0[2], silu_f(g0[3]) * u0[3]);
                w.z = pk_bf16(silu_f(g1[0]) * u1[0], silu_f(g1[1]) * u1[1]); w.w = pk_bf16(silu_f(g1[2]) * u1[2], silu_f(g1[3]) * u1[3]);
                *(u32x4*)(ACT + (size_t)row * DFF + f) = w; }
    }
    __device__ __forceinline__ int brow(int tau, int n) const { return 256 * (tau >> 3) + 16 * (tau & 7) + 128 * n; }
    __device__ __forceinline__ void sk(int row, int tau, int fq, const f32x4 v0, const f32x4 v1) const {
        const float rs = rs_of(ssq, row); const int f = 128 * (tau >> 3) + 16 * (tau & 7) + 4 * fq;
        const f32x4 g0 = v0 * rs, u0 = v1 * rs;
        u32x2 w; w.x = pk_bf16(silu_f(g0[0]) * u0[0], silu_f(g0[1]) * u0[1]); w.y = pk_bf16(silu_f(g0[2]) * u0[2], silu_f(g0[3]) * u0[3]);
        *(u32x2*)(ACT + (size_t)row * DFF + f) = w;
    }
};
struct EpiProj {
    static constexpr bool PERM = true;
    bf16_t* PROJ; const float* ssq; const float* rsb;
    __device__ __forceinline__ void operator()(const f32x4 (&acc)[2][2][4][2], const Unit& u, int ui, int wr, int wc, int fr, int fq) const {
        float rsv[2][4];
#pragma unroll
        for (int ai = 0; ai < 2; ++ai)
#pragma unroll
            for (int m = 0; m < 4; ++m) rsv[ai][m] = rsb[ui * 256 + ai * 128 + wr * 64 + m * 16 + fr];
#pragma unroll
        for (int ai = 0; ai < 2; ++ai)
#pragma unroll
            for (int m = 0; m < 4; ++m) {
                const int row = u.pm * 256 + ai * 128 + wr * 64 + m * 16 + fr; const float rs = rsv[ai][m];
#pragma unroll
                for (int bj = 0; bj < 2; ++bj) {
                    const int col = u.pn * 256 + bj * 128 + wc * 32 + 8 * fq;
                    const f32x4 a = acc[ai][bj][m][0] * rs, b = acc[ai][bj][m][1] * rs;
                    u32x4 w; w.x = pk_bf16(a[0], a[1]); w.y = pk_bf16(a[2], a[3]); w.z = pk_bf16(b[0], b[1]); w.w = pk_bf16(b[2], b[3]);
                    *(u32x4*)(PROJ + (size_t)row * 4096 + col) = w; } }
    }
    __device__ __forceinline__ int brow(int tau, int n) const { return 32 * tau + 16 * n; }
    __device__ __forceinline__ void sk(int row, int tau, int fq, const f32x4 v0, const f32x4 v1) const {
        const float rs = rs_of(ssq, row);
#pragma unroll
        for (int n = 0; n < 2; ++n) { const f32x4 a = (n ? v1 : v0) * rs; u32x2 w; w.x = pk_bf16(a[0], a[1]); w.y = pk_bf16(a[2], a[3]);
            *(u32x2*)(PROJ + (size_t)row * 4096 + 32 * tau + 16 * n + 4 * fq) = w; }
    }
};
struct EpiRes {
    static constexpr bool PERM = true;
    bf16_t* xb; float* ssq_out;
    __device__ __forceinline__ void operator()(const f32x4 (&acc)[2][2][4][2], const Unit& u, int ui, int wr, int wc, int fr, int fq) const {
#pragma unroll
        for (int ai = 0; ai < 2; ++ai) {
            u32x4 xv[4][2];
#pragma unroll
            for (int m = 0; m < 4; ++m)
#pragma unroll
                for (int bj = 0; bj < 2; ++bj) xv[m][bj] = *(const u32x4*)(xb + (size_t)(u.pm * 256 + ai * 128 + wr * 64 + m * 16 + fr) * D + u.pn * 256 + bj * 128 + wc * 32 + 8 * fq);
#pragma unroll
            for (int m = 0; m < 4; ++m) {
                const int row = u.pm * 256 + ai * 128 + wr * 64 + m * 16 + fr; f32x2 ss = (f32x2){0.f, 0.f};
#pragma unroll
                for (int bj = 0; bj < 2; ++bj) {
                    const size_t o = (size_t)row * D + u.pn * 256 + bj * 128 + wc * 32 + 8 * fq;
                    const u32x4 xo = xv[m][bj];
                    const f32x4 x0 = (f32x4){bf_lo(xo.x), bf_hi(xo.x), bf_lo(xo.y), bf_hi(xo.y)} + acc[ai][bj][m][0];
                    const f32x4 x1 = (f32x4){bf_lo(xo.z), bf_hi(xo.z), bf_lo(xo.w), bf_hi(xo.w)} + acc[ai][bj][m][1];
                    u32x4 w; w.x = pk_bf16(x0[0], x0[1]); w.y = pk_bf16(x0[2], x0[3]); w.z = pk_bf16(x1[0], x1[1]); w.w = pk_bf16(x1[2], x1[3]); *(u32x4*)(xb + o) = w;
                    ss[bj] += ((x0[0] * x0[0] + x0[1] * x0[1]) + (x0[2] * x0[2] + x0[3] * x0[3])) + ((x1[0] * x1[0] + x1[1] * x1[1]) + (x1[2] * x1[2] + x1[3] * x1[3])); }
                ss[0] += __shfl_xor(ss[0], 16); ss[1] += __shfl_xor(ss[1], 16); ss[0] += __shfl_xor(ss[0], 32); ss[1] += __shfl_xor(ss[1], 32);
                if (fq == 0) *(f32x2*)(ssq_out + (size_t)row * 32 + (u.pn * 4 + wc) * 2) = ss; }
            asm volatile("" ::: "memory"); }
    }
    __device__ __forceinline__ int brow(int tau, int n) const { return 32 * tau + 16 * n; }
    __device__ __forceinline__ void sk(int row, int tau, int fq, const f32x4 v0, const f32x4 v1) const {
        float ss = 0.f;
#pragma unroll
        for (int n = 0; n < 2; ++n) {
            const int c = 32 * tau + 16 * n + 4 * fq; const size_t o = (size_t)row * D + c;
            const u32x2 xo = *(const u32x2*)(xb + o);
            const f32x4 x = (f32x4){bf_lo(xo.x), bf_hi(xo.x), bf_lo(xo.y), bf_hi(xo.y)} + (n ? v1 : v0);
            u32x2 w; w.x = pk_bf16(x[0], x[1]); w.y = pk_bf16(x[2], x[3]); *(u32x2*)(xb + o) = w;
            ss += (x[0] * x[0] + x[1] * x[1]) + (x[2] * x[2] + x[3] * x[3]); }
        ss += __shfl_xor(ss, 16); ss += __shfl_xor(ss, 32);
        if (fq == 0) ssq_out[(size_t)row * 32 + tau] = ss;
    }
};

template <class Epi>
__device__ __forceinline__ void skinny_gemm(unsigned char* shm, const bf16_t* Xs, const bf16_t* Bt, int K, int ntiles, const Epi& E, int first, int stride) {
    const int tid = opaque_tid(), w = tid >> 6, lane = tid & 63, fr = lane & 15, fq = lane >> 4;
    const int kper = K >> 3, kbeg = w * kper;
    f32x4* red = (f32x4*)shm;
    for (int tau = first; tau < ntiles; tau += stride) {
        f32x4 acc[8][2];
#pragma unroll
        for (int m = 0; m < 8; ++m) { acc[m][0] = (f32x4){0.f, 0.f, 0.f, 0.f}; acc[m][1] = (f32x4){0.f, 0.f, 0.f, 0.f}; }
        const bf16_t* bp0 = Bt + (size_t)(E.brow(tau, 0) + fr) * K + kbeg + 8 * fq;
        const bf16_t* bp1 = Bt + (size_t)(E.brow(tau, 1) + fr) * K + kbeg + 8 * fq;
        const bf16_t* ap = Xs + (size_t)fr * K + kbeg + 8 * fq;
        for (int k = 0; k < kper; k += 32) {
            const bf16x8 b0 = *(const bf16x8*)(bp0 + k), b1 = *(const bf16x8*)(bp1 + k);
            bf16x8 a[8];
#pragma unroll
            for (int m = 0; m < 8; ++m) a[m] = *(const bf16x8*)(ap + (size_t)m * 16 * K + k);
#pragma unroll
            for (int m = 0; m < 8; ++m) { acc[m][0] = __builtin_amdgcn_mfma_f32_16x16x32_bf16(b0, a[m], acc[m][0], 0, 0, 0); acc[m][1] = __builtin_amdgcn_mfma_f32_16x16x32_bf16(b1, a[m], acc[m][1], 0, 0, 0); }
        }
#pragma unroll
        for (int m = 0; m < 8; ++m) { red[(w * 16 + m * 2 + 0) * 64 + lane] = acc[m][0]; red[(w * 16 + m * 2 + 1) * 64 + lane] = acc[m][1]; }
        __syncthreads();
        f32x4 v0 = (f32x4){0.f, 0.f, 0.f, 0.f}, v1 = v0;
#pragma unroll
        for (int w2 = 0; w2 < 8; ++w2) { v0 += red[(w2 * 16 + w * 2 + 0) * 64 + lane]; v1 += red[(w2 * 16 + w * 2 + 1) * 64 + lane]; }
        __syncthreads();
        E.sk(MP + 16 * w + fr, tau, fq, v0, v1);
    }
}

__device__ __forceinline__ void transpose_tile(const float* W, int ldw, int k0, int nsrc0, const float* gain, bf16_t* dst, int K, int ndst0, bf16_t* scr, int lane) {
#pragma unroll 4
    for (int i = 0; i < 16; ++i) {
        const int k = 4 * i + (lane >> 4), n4 = (lane & 15) * 4;
        const f32x4 v = *(const f32x4*)(W + (size_t)(k0 + k) * ldw + nsrc0 + n4);
        const float gk = gain ? gain[k0 + k] : 1.f;
        const unsigned p0 = pk_bf16(v[0] * gk, v[1] * gk), p1 = pk_bf16(v[2] * gk, v[3] * gk);
        scr[(n4 + 0) * 72 + k] = (bf16_t)(p0 & 0xffffu); scr[(n4 + 1) * 72 + k] = (bf16_t)(p0 >> 16);
        scr[(n4 + 2) * 72 + k] = (bf16_t)(p1 & 0xffffu); scr[(n4 + 3) * 72 + k] = (bf16_t)(p1 >> 16);
    }
    asm volatile("s_waitcnt lgkmcnt(0)" ::: "memory");
#pragma unroll
    for (int j = 0; j < 8; ++j) { const int n = (lane >> 3) + 8 * j, c = lane & 7;
        const u32x4 o = *(const u32x4*)(scr + n * 72 + 8 * c); *(u32x4*)(dst + (size_t)(ndst0 + n) * K + k0 + 8 * c) = o; }
    asm volatile("s_waitcnt lgkmcnt(0)" ::: "memory");
}
__device__ __forceinline__ void phase_pre(const Params& p, unsigned char* shm) {
    const int tid = opaque_tid(), w = tid >> 6, lane = tid & 63;
    const int gw = blockIdx.x * 8 + w, NGW = gridDim.x * 8, gt = blockIdx.x * 512 + tid, NGT = gridDim.x * 512;
    unsigned char* ws = p.ws;
    float* ssq = (float*)(ws + A_SSQ);
    bf16_t* xb = (bf16_t*)(ws + A_XB);
    for (int row = gw; row < MT; row += NGW) {
        const float* src = row < MP ? p.in[0] + (size_t)row * D : p.in[1] + (size_t)(row - MP) * D;
        float ss = 0.f;
#pragma unroll
        for (int j = 0; j < 4; ++j) { const f32x4 v = *(const f32x4*)(src + 4 * lane + 256 * j); ss += (v[0] * v[0] + v[1] * v[1]) + (v[2] * v[2] + v[3] * v[3]);
            u32x2 o; o.x = pk_bf16(v[0], v[1]); o.y = pk_bf16(v[2], v[3]); *(u32x2*)(xb + (size_t)row * D + 4 * lane + 256 * j) = o; }
        ss = wave_sum(ss);
        if (lane < 32) ssq[(size_t)row * 32 + lane] = lane == 0 ? ss : 0.f;
    }
    bf16_t* wba = (bf16_t*)(ws + W_BA);
    if (gt < 2 * 16 * 1024) { const int i = gt;     const int j = i >> 14, n = (i >> 10) & 15, k = i & 1023;
        const float v = p.in[12][((size_t)j * 1024 + k) * BIN + 4096 + n] * p.in[4][(2 * j + 1) * 1024 + k];
        wba[i] = (bf16_t)(pk_bf16(v, 0.f) & 0xffffu); }
    bf16_t* scr = (bf16_t*)(shm + w * 9216);
    for (int it = gw; it < 14080; it += NGW) {
        int r = it;
        if (r < 2048) { const int j = r >> 10; r &= 1023; const int kt = r >> 6, nt = r & 63;
            transpose_tile(p.in[7] + (size_t)j * 1024 * 4096, 4096, kt * 64, nt * 64, p.in[4] + (2 * j) * 1024, (bf16_t*)(ws + W_AIN) + (size_t)j * 4096 * 1024, 1024, nt * 64, scr, lane); continue; }
        r -= 2048;
        if (r < 1024) { const int j = r >> 9; r &= 511; const int kt = r >> 4, nt = r & 15;
            transpose_tile(p.in[11] + (size_t)j * 2048 * 1024, 1024, kt * 64, nt * 64, nullptr, (bf16_t*)(ws + W_AOUT) + (size_t)j * 1024 * 2048, 2048, nt * 64, scr, lane); continue; }
        r -= 1024;
        if (r < 2048) { const int j = r >> 10; r &= 1023; const int kt = r >> 6, nt = r & 63;
            transpose_tile(p.in[12] + (size_t)j * 1024 * BIN, BIN, kt * 64, nt * 64, p.in[4] + (2 * j + 1) * 1024, (bf16_t*)(ws + W_BIN) + (size_t)j * 4096 * 1024, 1024, nt * 64, scr, lane); continue; }
        r -= 2048;
        if (r < 512) { const int j = r >> 8; r &= 255; const int kt = r >> 4, nt = r & 15;
            transpose_tile(p.in[17] + (size_t)j * 1024 * 1024, 1024, kt * 64, nt * 64, nullptr, (bf16_t*)(ws + W_BOUT) + (size_t)j * 1024 * 1024, 1024, nt * 64, scr, lane); continue; }
        r -= 512;
        if (r < 5632) { const int l = r / 1408; r -= l * 1408; const int kt = r / 88, nt = r - kt * 88; const int nd = nt * 64, pn = nd >> 8, hh = (nd >> 7) & 1, ii = nd & 127;
            transpose_tile(p.in[18] + (size_t)l * 1024 * NFIN, NFIN, kt * 64, hh * DFF + 128 * pn + ii, p.in[5] + l * 1024, (bf16_t*)(ws + W_FIN) + (size_t)l * NFIN * 1024, 1024, nd, scr, lane); continue; }
        r -= 5632;
        { const int l = r / 704; r -= l * 704; const int kt = r >> 4, nt = r & 15;
            transpose_tile(p.in[19] + (size_t)l * DFF * 1024, 1024, kt * 64, nt * 64, nullptr, (bf16_t*)(ws + W_FOUT) + (size_t)l * 1024 * DFF, DFF, nt * 64, scr, lane); }
    }
}

__device__ __forceinline__ void phase_mix(const Params& p, int j, unsigned char* shm) {
    const int tid = opaque_tid(), w = tid >> 6, lane = tid & 63, fr = lane & 15, fq = lane >> 4;
    unsigned char* ws = p.ws;
    const bf16_t* VT = (const bf16_t*)(ws + R_VT); const bf16_t* U = (const bf16_t*)(ws + R_U); bf16_t* P = (bf16_t*)(ws + R_P);
    const float* Wsp = p.in[9] + (size_t)j * 8 * 128 * 128; const float* bsp = p.in[10] + j * 8 * 128; const float* gv = p.in[8] + j * DA;
    float* sred = (float*)shm; float* rvs = (float*)(shm + 16384); bf16_t* Wl = (bf16_t*)(shm + 16384 + 512);
    for (int task = blockIdx.x; task < 256; task += gridDim.x) {
        const int c = task >> 1, hg = task & 1;
        if (tid < 128) { const f32x4* q = (const f32x4*)((const float*)(ws + A_VSQ) + ((size_t)c * 128 + tid) * 32); f32x4 a = q[0];
#pragma unroll
            for (int i = 1; i < 8; ++i) a += q[i];
            rvs[tid] = rsqrtf(((a[0] + a[1]) + (a[2] + a[3])) * (1.f / 2048.f) + EPS); }
        __syncthreads();
        for (int gi = 0; gi < 4; ++gi) {
            const int g = hg * 4 + gi;
            {   const int t = tid >> 2, s0 = (tid & 3) * 32; const float* wrow = Wsp + (size_t)(g * 128 + t) * 128 + s0;
#pragma unroll
                for (int q = 0; q < 8; ++q) { const int s = s0 + 4 * q; f32x4 v = *(const f32x4*)(wrow + 4 * q); const f32x4 r4 = *(const f32x4*)(rvs + s); v = v * r4;
                    v[0] = (s + 0 <= t) ? v[0] : 0.f; v[1] = (s + 1 <= t) ? v[1] : 0.f; v[2] = (s + 2 <= t) ? v[2] : 0.f; v[3] = (s + 3 <= t) ? v[3] : 0.f;
                    u32x2 o; o.x = pk_bf16(v[0], v[1]); o.y = pk_bf16(v[2], v[3]); *(u32x2*)(Wl + t * 136 + s) = o; } }
            __syncthreads();
            f32x4 acc[8][2];
#pragma unroll
            for (int m = 0; m < 8; ++m) { acc[m][0] = (f32x4){0.f, 0.f, 0.f, 0.f}; acc[m][1] = (f32x4){0.f, 0.f, 0.f, 0.f}; }
            const bf16_t* bp = VT + (size_t)(g * 256 + 32 * w + 8 * (fr >> 2) + (fr & 3)) * MP + c * 128 + 8 * fq;
#pragma unroll
            for (int ks = 0; ks < 4; ++ks) {
                const bf16x8 b0 = *(const bf16x8*)(bp + 32 * ks), b1 = *(const bf16x8*)(bp + (size_t)4 * MP + 32 * ks);
#pragma unroll
                for (int m = 0; m < 8; ++m) if (32 * ks <= 16 * m + 15) {
                    const bf16x8 a = *(const bf16x8*)(Wl + (16 * m + fr) * 136 + 32 * ks + 8 * fq);
                    acc[m][0] = __builtin_amdgcn_mfma_f32_16x16x32_bf16(b0, a, acc[m][0], 0, 0, 0); acc[m][1] = __builtin_amdgcn_mfma_f32_16x16x32_bf16(b1, a, acc[m][1], 0, 0, 0); }
            }
#pragma unroll
            for (int m = 0; m < 8; ++m) { const int t = 16 * m + fr; const float bias = bsp[g * 128 + t]; const size_t row = (size_t)c * 128 + t;
                const int col = g * 256 + 32 * w + 8 * fq; const f32x4 ga = *(const f32x4*)(gv + col), gb = *(const f32x4*)(gv + col + 4);
                const u32x4 uu = *(const u32x4*)(U + row * DA + col); const f32x4 m0 = ga * acc[m][0] + bias, m1 = gb * acc[m][1] + bias;
                u32x4 o; o.x = pk_bf16(bf_lo(uu.x) * m0[0], bf_hi(uu.x) * m0[1]); o.y = pk_bf16(bf_lo(uu.y) * m0[2], bf_hi(uu.y) * m0[3]);
                o.z = pk_bf16(bf_lo(uu.z) * m1[0], bf_hi(uu.z) * m1[1]); o.w = pk_bf16(bf_lo(uu.w) * m1[2], bf_hi(uu.w) * m1[3]);
                *(u32x4*)(P + row * DA + col) = o; }
            __syncthreads();
        }
    }
    const int gw = blockIdx.x * 8 + w;
    if (gw < MS) {
        const int b = gw; const float* vs = (const float*)(ws + A_VS) + (size_t)b * DA; float* vout = p.out + O_CV + ((size_t)j * MS + b) * DA;
        f32x4 v[8]; float ss = 0.f;
#pragma unroll
        for (int i = 0; i < 8; ++i) { v[i] = *(const f32x4*)(vs + i * 256 + lane * 4); ss += (v[i][0] * v[i][0] + v[i][1] * v[i][1]) + (v[i][2] * v[i][2] + v[i][3] * v[i][3]); }
        ss = wave_sum(ss); const float rv = rsqrtf(ss * (1.f / 2048.f) + EPS);
#pragma unroll
        for (int i = 0; i < 8; ++i) { const int col = i * 256 + lane * 4; const f32x4 vn = v[i] * rv * *(const f32x4*)(gv + col);
            *(f32x4*)(vout + col) = vn;
            const float w00 = Wsp[(size_t)i * 128 * 128], b0 = bsp[i * 128];
            const f32x4 mx = vn * w00 + b0; const size_t o = (size_t)(MP + b) * DA + col; const u32x2 uu = *(const u32x2*)(U + o);
            u32x2 r; r.x = pk_bf16(bf_lo(uu.x) * mx[0], bf_hi(uu.x) * mx[1]); r.y = pk_bf16(bf_lo(uu.y) * mx[2], bf_hi(uu.y) * mx[3]); *(u32x2*)(P + o) = r; }
    }
}

__device__ __forceinline__ void phase_ba(const Params& p, int lj, int l) {
    const int tid = opaque_tid(), w = tid >> 6, lane = tid & 63, fr = lane & 15, fq = lane >> 4;
    const int gw = blockIdx.x * 8 + w, NGW = gridDim.x * 8;
    unsigned char* ws = p.ws; const bf16_t* xb = (const bf16_t*)(ws + A_XB); const bf16_t* wba = (const bf16_t*)(ws + W_BA) + (size_t)lj * 16 * 1024;
    const float* ssq = (const float*)(ws + A_SSQ) + (size_t)(2 * l) * MT * 32; float* ba = (float*)(ws + A_BA);
    for (int task = w * (int)gridDim.x + (int)blockIdx.x; task < MT / 16; task += NGW) {
        f32x4 acc = (f32x4){0.f, 0.f, 0.f, 0.f};
        const bf16_t* ap = xb + (size_t)(task * 16 + fr) * D + 8 * fq; const bf16_t* bp = wba + (size_t)fr * D + 8 * fq;
#pragma unroll 8
        for (int k = 0; k < D; k += 32) acc = __builtin_amdgcn_mfma_f32_16x16x32_bf16(*(const bf16x8*)(bp + k), *(const bf16x8*)(ap + k), acc, 0, 0, 0);
        const int row = task * 16 + fr; const float rs = rs_of(ssq, row);
        *(f32x4*)(ba + (size_t)row * 16 + 4 * fq) = acc * rs;
    }
}

__device__ __forceinline__ void unpack8(const u32x4 q, float (&o)[8]) { o[0] = bf_lo(q.x); o[1] = bf_hi(q.x); o[2] = bf_lo(q.y); o[3] = bf_hi(q.y); o[4] = bf_lo(q.z); o[5] = bf_hi(q.z); o[6] = bf_lo(q.w); o[7] = bf_hi(q.w); }
__device__ __forceinline__ void phase_conv(const Params& p, int lj) {
    const int tid = opaque_tid(), w = tid >> 6, lane = tid & 63;
    const int gw = blockIdx.x * 8 + w, NGW = gridDim.x * 8;
    unsigned char* ws = p.ws; const bf16_t* PROJ = (const bf16_t*)(ws + R_PROJ);
    bf16_t* QN = (bf16_t*)(ws + R_QN); bf16_t* KN = (bf16_t*)(ws + R_KN); bf16_t* VV = (bf16_t*)(ws + R_VV);
    const float* ba = (const float*)(ws + A_BA); float* be = (float*)(ws + A_BE);
    const float* wconv = p.in[13] + (size_t)lj * 4 * QKV; const float* sconv = p.in[3] + (size_t)lj * MS * 3 * QKV;
    for (int task = gw; task < MP / 8; task += NGW) {
        const int row0 = task * 8, b = row0 >> 11, t0 = row0 & 2047;
#pragma unroll 1
        for (int i = 0; i < 6; ++i) {
            const int c0 = i * 512 + lane * 8;
            f32x4 wa[4], wb[4];
#pragma unroll
            for (int jj = 0; jj < 4; ++jj) { wa[jj] = *(const f32x4*)(wconv + (size_t)jj * QKV + c0); wb[jj] = *(const f32x4*)(wconv + (size_t)jj * QKV + c0 + 4); }
            u32x4 win[3], cur[8];
#pragma unroll
            for (int jj = 0; jj < 3; ++jj) { win[jj] = (u32x4){0u, 0u, 0u, 0u}; if (t0 > 0) win[jj] = *(const u32x4*)(PROJ + (size_t)(row0 - 3 + jj) * 4096 + c0); }
#pragma unroll
            for (int r = 0; r < 8; ++r) cur[r] = *(const u32x4*)(PROJ + (size_t)(row0 + r) * 4096 + c0);
#pragma unroll
            for (int r = 0; r < 8; ++r) {
                const int row = row0 + r, t = t0 + r;
                float a0[8], a1[8], a2[8], a3[8]; unpack8(win[0], a0); unpack8(win[1], a1); unpack8(win[2], a2); unpack8(cur[r], a3);
                if (t >= 2045) { float* oc = p.out + O_CP + (((size_t)lj * 8 + b) * 3 + (t - 2045)) * QKV + c0;
                    *(f32x4*)oc = (f32x4){a3[0], a3[1], a3[2], a3[3]}; *(f32x4*)(oc + 4) = (f32x4){a3[4], a3[5], a3[6], a3[7]}; }
                float y[8];
#pragma unroll
                for (int e = 0; e < 4; ++e) { y[e] = a0[e] * wa[0][e] + a1[e] * wa[1][e] + a2[e] * wa[2][e] + a3[e] * wa[3][e]; y[4 + e] = a0[4 + e] * wb[0][e] + a1[4 + e] * wb[1][e] + a2[4 + e] * wb[2][e] + a3[4 + e] * wb[3][e]; }
                float ss = 0.f;
#pragma unroll
                for (int e = 0; e < 8; ++e) { y[e] = silu_f(y[e]); ss += y[e] * y[e]; }
                float sc = 1.f;
                if (i < 4) { ss = sum16(ss); sc = rsqrtf(ss + EPS); if (i < 2) sc *= 0.08838834764831845f; }
                u32x4 o; o.x = pk_bf16(y[0] * sc, y[1] * sc); o.y = pk_bf16(y[2] * sc, y[3] * sc); o.z = pk_bf16(y[4] * sc, y[5] * sc); o.w = pk_bf16(y[6] * sc, y[7] * sc);
                bf16_t* dst = (i < 2 ? QN : (i < 4 ? KN : VV)) + (size_t)row * D + (c0 & 1023);
                *(u32x4*)dst = o;
                win[0] = win[1]; win[1] = win[2]; win[2] = cur[r];
            }
        }
        {   const int row = row0 + (lane >> 3), hh = lane & 7;
            const float braw = ba[(size_t)row * 16 + hh], araw = ba[(size_t)row * 16 + 8 + hh];
            const float beta = 1.f / (1.f + expf(-braw));
            const float xs = araw + p.in[15][lj * 8 + hh]; const float sp = xs > 20.f ? xs : log1pf(expf(xs));
            const float gg = -expf(p.in[14][lj * 8 + hh]) * sp;
            be[(size_t)row * 16 + hh] = beta; be[(size_t)row * 16 + 8 + hh] = gg; }
    }
    for (int sb = w * (int)gridDim.x + (int)blockIdx.x; sb < MS; sb += NGW) {
        const int b = sb, row = MP + sb;
#pragma unroll 1
        for (int i = 0; i < 6; ++i) {
            const int c0 = i * 512 + lane * 8;
            float raw[4][8];
            unpack8(*(const u32x4*)(PROJ + (size_t)row * 4096 + c0), raw[3]);
#pragma unroll
            for (int jj = 0; jj < 3; ++jj) { const float* sp_ = sconv + ((size_t)b * 3 + jj) * QKV + c0; const f32x4 a = *(const f32x4*)sp_, c = *(const f32x4*)(sp_ + 4);
                raw[jj][0] = a[0]; raw[jj][1] = a[1]; raw[jj][2] = a[2]; raw[jj][3] = a[3]; raw[jj][4] = c[0]; raw[jj][5] = c[1]; raw[jj][6] = c[2]; raw[jj][7] = c[3]; }
            float* oc = p.out + O_CS + ((size_t)lj * MS + b) * 3 * QKV + c0;
#pragma unroll
            for (int jj = 0; jj < 3; ++jj) { const int sj = jj + 1;
                *(f32x4*)(oc + (size_t)jj * QKV) = (f32x4){raw[sj][0], raw[sj][1], raw[sj][2], raw[sj][3]}; *(f32x4*)(oc + (size_t)jj * QKV + 4) = (f32x4){raw[sj][4], raw[sj][5], raw[sj][6], raw[sj][7]}; }
            float y[8];
#pragma unroll
            for (int e = 0; e < 8; ++e) y[e] = 0.f;
#pragma unroll
            for (int jj = 0; jj < 4; ++jj) { const f32x4 wa = *(const f32x4*)(wconv + (size_t)jj * QKV + c0), wb = *(const f32x4*)(wconv + (size_t)jj * QKV + c0 + 4);
                y[0] += raw[jj][0] * wa[0]; y[1] += raw[jj][1] * wa[1]; y[2] += raw[jj][2] * wa[2]; y[3] += raw[jj][3] * wa[3];
                y[4] += raw[jj][4] * wb[0]; y[5] += raw[jj][5] * wb[1]; y[6] += raw[jj][6] * wb[2]; y[7] += raw[jj][7] * wb[3]; }
            float ss = 0.f;
#pragma unroll
            for (int e = 0; e < 8; ++e) { y[e] = silu_f(y[e]); ss += y[e] * y[e]; }
            float sc = 1.f;
            if (i < 4) { ss = sum16(ss); sc = rsqrtf(ss + EPS); if (i < 2) sc *= 0.08838834764831845f; }
            u32x4 o; o.x = pk_bf16(y[0] * sc, y[1] * sc); o.y = pk_bf16(y[2] * sc, y[3] * sc); o.z = pk_bf16(y[4] * sc, y[5] * sc); o.w = pk_bf16(y[6] * sc, y[7] * sc);
            bf16_t* dst = (i < 2 ? QN : (i < 4 ? KN : VV)) + (size_t)row * D + (c0 & 1023);
            *(u32x4*)dst = o;
        }
        if (lane < 8) {
            const float braw = ba[(size_t)row * 16 + lane], araw = ba[(size_t)row * 16 + 8 + lane];
            const float beta = 1.f / (1.f + expf(-braw));
            const float xs = araw + p.in[15][lj * 8 + lane]; const float sp = xs > 20.f ? xs : log1pf(expf(xs));
            const float gg = -expf(p.in[14][lj * 8 + lane]) * sp;
            be[(size_t)row * 16 + lane] = beta; be[(size_t)row * 16 + 8 + lane] = gg;
        }
    }
}

__device__ __forceinline__ void phase_prep(const Params& p, int lj, unsigned char* shm) {
    const int tid = opaque_tid(), w = tid >> 6, lane = tid & 63, fr = lane & 15, fq = lane >> 4;
    const int grp = w >> 2, wl = w & 3, gtid = tid & 255;
    unsigned char* ws = p.ws; bf16_t* QN = (bf16_t*)(ws + R_QN); bf16_t* KN = (bf16_t*)(ws + R_KN); bf16_t* VV = (bf16_t*)(ws + R_VV); bf16_t* PROJ = (bf16_t*)(ws + R_PROJ);
    const float* BE = (const float*)(ws + A_BE); float* EGL = (float*)(ws + A_BA);
    float* Lf = (float*)(shm + grp * 18432); float* gcs = Lf + 64 * 68; float* bts = gcs + 64;
    for (int it = 0; it < 4; ++it) {
        const int task = blockIdx.x * 8 + it * 2 + grp;
        if (task >= 2048) break;
        const int b = task >> 8, h = (task >> 5) & 7, n = task & 31; const size_t r0 = (size_t)b * 2048 + n * 64;
        if (wl == 0) {
            float g = BE[(r0 + lane) * 16 + 8 + h]; const float bt = BE[(r0 + lane) * 16 + h];
#pragma unroll
            for (int o = 1; o < 64; o <<= 1) { const float t = __shfl_up(g, o); if (lane >= o) g += t; }
            gcs[lane] = g; bts[lane] = bt; if (lane == 63) EGL[task] = expf(g);
        }
        __syncthreads();
        {
            const int ib = wl; bf16x8 kf[4], qf[4];
#pragma unroll
            for (int ks = 0; ks < 4; ++ks) { kf[ks] = *(const bf16x8*)(KN + (r0 + 16 * ib + fr) * D + h * 128 + 32 * ks + 8 * fq); qf[ks] = *(const bf16x8*)(QN + (r0 + 16 * ib + fr) * D + h * 128 + 32 * ks + 8 * fq); }
            const int i = 16 * ib + fr; const float gi = gcs[i], bi = bts[i];
            for (int jb = 0; jb < 4; ++jb) {
                bf16_t* adst = PROJ + (r0 + i) * 4096 + h * 128 + 16 * jb + 4 * fq;
                if (jb > ib) { *(u32x2*)adst = (u32x2){0u, 0u}; continue; }
                f32x4 aK = (f32x4){0.f, 0.f, 0.f, 0.f}, aQ = aK;
#pragma unroll
                for (int ks = 0; ks < 4; ++ks) { const bf16x8 bfr = *(const bf16x8*)(KN + (r0 + 16 * jb + fr) * D + h * 128 + 32 * ks + 8 * fq);
                    aK = __builtin_amdgcn_mfma_f32_16x16x32_bf16(bfr, kf[ks], aK, 0, 0, 0); aQ = __builtin_amdgcn_mfma_f32_16x16x32_bf16(bfr, qf[ks], aQ, 0, 0, 0); }
                f32x4 Lv, Av;
#pragma unroll
                for (int r = 0; r < 4; ++r) { const int j = 16 * jb + 4 * fq + r; const float e = (i >= j) ? __expf(gi - gcs[j]) : 0.f; Lv[r] = (i > j) ? bi * aK[r] * e : 0.f; Av[r] = aQ[r] * e; }
                *(f32x4*)(Lf + i * 68 + 16 * jb + 4 * fq) = Lv;
                u32x2 o; o.x = pk_bf16(Av[0], Av[1]); o.y = pk_bf16(Av[2], Av[3]); *(u32x2*)adst = o;
            }
        }
        u32x4 qreg[4];
        { const int row = gtid >> 2, seg = gtid & 3;
#pragma unroll
          for (int e = 0; e < 4; ++e) qreg[e] = *(const u32x4*)(QN + (r0 + row) * D + h * 128 + seg * 32 + 8 * e); }
        float x[64];
        { const bf16_t* src = (wl < 2 ? VV : KN) + r0 * D + h * 128 + (wl & 1) * 64 + lane;
#pragma unroll
          for (int i = 0; i < 64; ++i) x[i] = __uint_as_float((unsigned)src[(size_t)i * D] << 16); }
        asm volatile("s_waitcnt vmcnt(0)" ::: "memory");
        __syncthreads();
        { const int row = gtid >> 2, seg = gtid & 3; const float e = __expf(gcs[row]);
#pragma unroll
          for (int q = 0; q < 4; ++q) { u32x4 o; o.x = pk_bf16(bf_lo(qreg[q].x) * e, bf_hi(qreg[q].x) * e); o.y = pk_bf16(bf_lo(qreg[q].y) * e, bf_hi(qreg[q].y) * e); o.z = pk_bf16(bf_lo(qreg[q].z) * e, bf_hi(qreg[q].z) * e); o.w = pk_bf16(bf_lo(qreg[q].w) * e, bf_hi(qreg[q].w) * e);
              *(u32x4*)(QN + (r0 + row) * D + h * 128 + seg * 32 + 8 * q) = o; } }
        const int col = (wl & 1) * 64 + lane;
        if (wl >= 2) {
            const float gl = gcs[63];
            bf16_t* kd = PROJ + (r0 + (col >> 1)) * 4096 + 1024 + h * 128 + (col & 1) * 64;
#pragma unroll
            for (int c8 = 0; c8 < 8; ++c8) { float t[8];
#pragma unroll
                for (int e = 0; e < 8; ++e) t[e] = x[c8 * 8 + e] * __expf(gl - gcs[c8 * 8 + e]);
                u32x4 o; o.x = pk_bf16(t[0], t[1]); o.y = pk_bf16(t[2], t[3]); o.z = pk_bf16(t[4], t[5]); o.w = pk_bf16(t[6], t[7]); *(u32x4*)(kd + c8 * 8) = o; }
#pragma unroll
            for (int i = 0; i < 64; ++i) x[i] *= bts[i] * __expf(gcs[i]);
        } else {
#pragma unroll
            for (int i = 0; i < 64; ++i) x[i] *= bts[i];
        }
#pragma unroll
        for (int i = 1; i < 64; ++i) {
            float a0 = x[i], a1 = 0.f, a2 = 0.f, a3 = 0.f;
#pragma unroll
            for (int j4 = 0; j4 < i; j4 += 4) { const f32x4 l4 = *(const f32x4*)(Lf + i * 68 + j4);
                a0 -= l4[0] * x[j4]; if (j4 + 1 < i) a1 -= l4[1] * x[j4 + 1]; if (j4 + 2 < i) a2 -= l4[2] * x[j4 + 2]; if (j4 + 3 < i) a3 -= l4[3] * x[j4 + 3]; }
            x[i] = (a0 + a1) + (a2 + a3);
        }
        if (wl < 2) {
            bf16_t* ut = VV + (r0 + (col >> 1)) * D + h * 128 + (col & 1) * 64;
#pragma unroll
            for (int c8 = 0; c8 < 8; ++c8) { u32x4 o; o.x = pk_bf16(x[c8 * 8 + 0], x[c8 * 8 + 1]); o.y = pk_bf16(x[c8 * 8 + 2], x[c8 * 8 + 3]); o.z = pk_bf16(x[c8 * 8 + 4], x[c8 * 8 + 5]); o.w = pk_bf16(x[c8 * 8 + 6], x[c8 * 8 + 7]); *(u32x4*)(ut + c8 * 8) = o; }
        } else {
            bf16_t* wd = KN + r0 * D + h * 128 + col;
#pragma unroll
            for (int i = 0; i < 64; ++i) wd[(size_t)i * D] = (bf16_t)(pk_bf16(x[i], 0.f) & 0xffffu);
        }
        __syncthreads();
    }
}

__device__ __forceinline__ void phase_scan(const Params& p, int lj, unsigned char* shm) {
    const int tid = opaque_tid(), w = tid >> 6, lane = tid & 63, fr = lane & 15, fq = lane >> 4, cb = w & 3, db = w >> 2;
    unsigned char* ws = p.ws; const bf16_t* QN = (const bf16_t*)(ws + R_QN); const bf16_t* KN = (const bf16_t*)(ws + R_KN); const bf16_t* VV = (const bf16_t*)(ws + R_VV); const bf16_t* PROJ = (const bf16_t*)(ws + R_PROJ);
    const float* EGL = (const float*)(ws + A_BA); bf16_t* OB = (bf16_t*)(ws + R_OB);
    bf16_t* ST = (bf16_t*)shm; bf16_t* VN = (bf16_t*)(shm + 8704);
    for (int task = blockIdx.x; task < 256; task += gridDim.x) {
        const int b = task & 7, h = task >> 5, vq = (task >> 3) & 3;
        f32x4 Sacc[2]; Sacc[0] = (f32x4){0.f, 0.f, 0.f, 0.f}; Sacc[1] = Sacc[0];
        for (int i = tid; i < 8704 / 4; i += 512) ((unsigned*)ST)[i] = 0u;
        __syncthreads();
        const int dvg = vq * 32 + 16 * db + fr, dkr = 16 * w + fr;
#define SCAN_BAR() do { asm volatile("s_waitcnt lgkmcnt(0)" ::: "memory"); __builtin_amdgcn_s_barrier(); asm volatile("" ::: "memory"); } while (0)
        const unsigned offRow = (unsigned)((16 * cb + fr) * D + 8 * fq), offA = (unsigned)((16 * cb + fr) * 4096 + 8 * fq), offKd = (unsigned)((dkr >> 1) * 4096 + 1024 + (dkr & 1) * 64 + 8 * fq), offUt = (unsigned)((dvg >> 1) * D + (dvg & 1) * 64 + 16 * cb + 4 * fq);
        const bf16_t* const bK = KN + (size_t)b * 2048 * D + h * 128; const bf16_t* const bQ = QN + (size_t)b * 2048 * D + h * 128; const bf16_t* const bV = VV + (size_t)b * 2048 * D + h * 128;
        const bf16_t* const bP = PROJ + (size_t)b * 2048 * 4096 + h * 128;
        bf16_t* const bO = OB + (size_t)b * 2048 * D + h * 128 + vq * 32; const unsigned offO = (unsigned)((16 * cb + fr) * D + 16 * db + 4 * fq);
#define SCAN_LOADC(N_, wf_, ut_) do { const int nn_ = (N_) < 32 ? (N_) : 31; \
            _Pragma("unroll") for (int ks = 0; ks < 4; ++ks) wf_[ks] = *(const bf16x8*)(bK + (size_t)nn_ * 64 * D + offRow + 32 * ks); \
            ut_ = *(const u32x2*)(bV + (size_t)nn_ * 64 * D + offUt); } while (0)
#define SCAN_LOADN(N_, qf_, af_, kdf_) do { const int nn_ = (N_) < 32 ? (N_) : 31; \
            _Pragma("unroll") for (int ks = 0; ks < 2; ++ks) kdf_[ks] = *(const bf16x8*)(bP + (size_t)nn_ * 64 * 4096 + offKd + 32 * ks); \
            _Pragma("unroll") for (int ks = 0; ks < 4; ++ks) qf_[ks] = *(const bf16x8*)(bQ + (size_t)nn_ * 64 * D + offRow + 32 * ks); \
            _Pragma("unroll") for (int ks = 0; ks < 2; ++ks) af_[ks] = *(const bf16x8*)(bP + (size_t)nn_ * 64 * 4096 + offA + 32 * ks); } while (0)
#define SCAN_STEP(N_, wf, utw, qf, af, kdf, nqf, naf, nkdf) do { const int n_ = (N_); \
            SCAN_LOADN(n_ + 1, nqf, naf, nkdf); \
            const float egs_ = EGL[(b * 8 + h) * 32 + n_]; \
            bf16x8 sf[4]; \
            _Pragma("unroll") for (int ks = 0; ks < 4; ++ks) sf[ks] = *(const bf16x8*)(ST + (16 * db + fr) * 136 + 32 * ks + 8 * fq); \
            f32x4 acc = (f32x4){0.f, 0.f, 0.f, 0.f}, oacc = acc; \
            _Pragma("unroll") for (int ks = 0; ks < 4; ++ks) acc = __builtin_amdgcn_mfma_f32_16x16x32_bf16(wf[ks], sf[ks], acc, 0, 0, 0); \
            { u32x2 o; o.x = pk_bf16(bf_lo(utw.x) - acc[0], bf_hi(utw.x) - acc[1]); o.y = pk_bf16(bf_lo(utw.y) - acc[2], bf_hi(utw.y) - acc[3]); *(u32x2*)(VN + (16 * db + fr) * 72 + 16 * cb + 4 * fq) = o; } \
            SCAN_LOADC(n_ + 2, wf, utw); \
            SCAN_BAR(); \
            _Pragma("unroll") for (int dvb = 0; dvb < 2; ++dvb) { Sacc[dvb] = Sacc[dvb] * egs_; \
                _Pragma("unroll") for (int ks = 0; ks < 2; ++ks) { const bf16x8 vnd = *(const bf16x8*)(VN + (16 * dvb + fr) * 72 + 32 * ks + 8 * fq); Sacc[dvb] = __builtin_amdgcn_mfma_f32_16x16x32_bf16(kdf[ks], vnd, Sacc[dvb], 0, 0, 0); } \
                u32x2 o; o.x = pk_bf16(Sacc[dvb][0], Sacc[dvb][1]); o.y = pk_bf16(Sacc[dvb][2], Sacc[dvb][3]); *(u32x2*)(ST + (16 * dvb + fr) * 136 + 16 * w + 4 * fq) = o; } \
            _Pragma("unroll") for (int ks = 0; ks < 4; ++ks) oacc = __builtin_amdgcn_mfma_f32_16x16x32_bf16(sf[ks], qf[ks], oacc, 0, 0, 0); \
            _Pragma("unroll") for (int ks = 0; ks < 2; ++ks) { const bf16x8 vnf = *(const bf16x8*)(VN + (16 * db + fr) * 72 + 32 * ks + 8 * fq); oacc = __builtin_amdgcn_mfma_f32_16x16x32_bf16(vnf, af[ks], oacc, 0, 0, 0); } \
            { u32x2 o; o.x = pk_bf16(oacc[0], oacc[1]); o.y = pk_bf16(oacc[2], oacc[3]); *(u32x2*)(bO + (size_t)n_ * 64 * D + offO) = o; } \
            SCAN_BAR(); } while (0)
        bf16x8 wf0[4], wf1[4], qfa[4], afa[2], kda[2], qfb[4], afb[2], kdb[2]; u32x2 ut0, ut1;
        SCAN_LOADC(0, wf0, ut0); SCAN_LOADN(0, qfa, afa, kda); SCAN_LOADC(1, wf1, ut1);
#pragma unroll 1
        for (int n = 0; n < 32; n += 2) {
            SCAN_STEP(n,     wf0, ut0, qfa, afa, kda, qfb, afb, kdb);
            SCAN_STEP(n + 1, wf1, ut1, qfb, afb, kdb, qfa, afa, kda);
        }
#undef SCAN_STEP
#undef SCAN_LOADC
#undef SCAN_LOADN
#undef SCAN_BAR
        float* So = p.out + O_DP + (((size_t)lj * 8 + b) * 8 + h) * 16384;
#pragma unroll
        for (int dvb = 0; dvb < 2; ++dvb)
#pragma unroll
            for (int r = 0; r < 4; ++r) So[(size_t)(16 * w + 4 * fq + r) * 128 + vq * 32 + 16 * dvb + fr] = Sacc[dvb][r];
        __syncthreads();
    }
}

__device__ __forceinline__ void phase_onorm(const Params& p, int lj, unsigned char* shm) {
    const int tid = opaque_tid(), w = tid >> 6, lane = tid & 63;
    const int gw = blockIdx.x * 8 + w, NGW = gridDim.x * 8;
    unsigned char* ws = p.ws; const bf16_t* OB = (const bf16_t*)(ws + R_OB); const bf16_t* PROJ = (const bf16_t*)(ws + R_PROJ); bf16_t* OG = (bf16_t*)(ws + R_OG);
    const bf16_t* QN = (const bf16_t*)(ws + R_QN); const bf16_t* KN = (const bf16_t*)(ws + R_KN); const bf16_t* VV = (const bf16_t*)(ws + R_VV);
    const float* BE = (const float*)(ws + A_BE); const float* go = p.in[16] + lj * 128;
    {
        float* pex = (float*)shm; float* oex = pex + 8 * 128;
        const int task = blockIdx.x * 4 + (w >> 1), half = __builtin_amdgcn_readfirstlane(w & 1);
        const bool live = task < MS * 8;
        const int b = live ? task >> 3 : 0, h = task & 7; const size_t row = MP + b;
        const float* S0 = p.in[2] + (((size_t)lj * MS + b) * 8 + h) * 16384 + (size_t)half * 64 * 128; float* S1 = p.out + O_DS + (((size_t)lj * MS + b) * 8 + h) * 16384 + (size_t)half * 64 * 128;
        f32x2 Sr[64];
#pragma unroll
        for (int i = 0; i < 64; ++i) Sr[i] = *(const f32x2*)(S0 + (size_t)i * 128 + 2 * lane);
        const unsigned kw = *(const unsigned*)(KN + row * D + h * 128 + 2 * lane), qw = *(const unsigned*)(QN + row * D + h * 128 + 2 * lane), vw = *(const unsigned*)(VV + row * D + h * 128 + 2 * lane);
        const float ka = bf_lo(kw), kb = bf_hi(kw), qa = bf_lo(qw), qb = bf_hi(qw), va = bf_lo(vw), vb = bf_hi(vw);
        const float beta = BE[row * 16 + h], eg = expf(BE[row * 16 + 8 + h]);
        f32x2 pp = (f32x2){0.f, 0.f};
#pragma unroll
        for (int i2 = 0; i2 < 32; ++i2) {
            const float kv0 = __int_as_float(__builtin_amdgcn_readlane(__float_as_int(ka), 32 * half + i2)), kv1 = __int_as_float(__builtin_amdgcn_readlane(__float_as_int(kb), 32 * half + i2));
            pp += Sr[2 * i2] * kv0 + Sr[2 * i2 + 1] * kv1; }
        *(f32x2*)(pex + w * 128 + 2 * lane) = pp;
        __syncthreads();
        { const f32x2 other = *(const f32x2*)(pex + (w ^ 1) * 128 + 2 * lane); pp += other; }
        const float d0 = beta * (va - eg * pp[0]), d1 = beta * (vb - eg * pp[1]);
        f32x2 oo = (f32x2){0.f, 0.f};
#pragma unroll
        for (int i2 = 0; i2 < 32; ++i2) {
            const float kv0 = __int_as_float(__builtin_amdgcn_readlane(__float_as_int(ka), 32 * half + i2)), kv1 = __int_as_float(__builtin_amdgcn_readlane(__float_as_int(kb), 32 * half + i2));
            const float qv0 = __int_as_float(__builtin_amdgcn_readlane(__float_as_int(qa), 32 * half + i2)), qv1 = __int_as_float(__builtin_amdgcn_readlane(__float_as_int(qb), 32 * half + i2));
            const f32x2 n0 = (f32x2){Sr[2 * i2][0] * eg + kv0 * d0, Sr[2 * i2][1] * eg + kv0 * d1}, n1 = (f32x2){Sr[2 * i2 + 1][0] * eg + kv1 * d0, Sr[2 * i2 + 1][1] * eg + kv1 * d1};
            if (live) { *(f32x2*)(S1 + (size_t)(2 * i2) * 128 + 2 * lane) = n0; *(f32x2*)(S1 + (size_t)(2 * i2 + 1) * 128 + 2 * lane) = n1; }
            oo += n0 * qv0 + n1 * qv1; }
        *(f32x2*)(oex + w * 128 + 2 * lane) = oo;
        __syncthreads();
        { const f32x2 other = *(const f32x2*)(oex + (w ^ 1) * 128 + 2 * lane); oo += other; }
        const float ss = wave_sum(oo[0] * oo[0] + oo[1] * oo[1]); const float r = rsqrtf(ss * (1.f / 128.f) + EPS);
        const unsigned gwd = *(const unsigned*)(PROJ + row * 4096 + QKV + h * 128 + 2 * lane);
        if (live && half == 0) *(unsigned*)(OG + row * D + h * 128 + 2 * lane) = pk_bf16(oo[0] * r * go[2 * lane] * silu_f(bf_lo(gwd)), oo[1] * r * go[2 * lane + 1] * silu_f(bf_hi(gwd)));
    }
    for (int row = gw; row < MP; row += NGW) {
#pragma unroll
        for (int i = 0; i < 2; ++i) {
            const int c0 = i * 512 + lane * 8;
            const u32x4 ow = *(const u32x4*)(OB + (size_t)row * D + c0); const u32x4 gwd = *(const u32x4*)(PROJ + (size_t)row * 4096 + QKV + c0);
            float o[8] = {bf_lo(ow.x), bf_hi(ow.x), bf_lo(ow.y), bf_hi(ow.y), bf_lo(ow.z), bf_hi(ow.z), bf_lo(ow.w), bf_hi(ow.w)};
            float gt[8] = {bf_lo(gwd.x), bf_hi(gwd.x), bf_lo(gwd.y), bf_hi(gwd.y), bf_lo(gwd.z), bf_hi(gwd.z), bf_lo(gwd.w), bf_hi(gwd.w)};
            float ss = 0.f;
#pragma unroll
            for (int e = 0; e < 8; ++e) ss += o[e] * o[e];
            ss = sum16(ss); const float r = rsqrtf(ss * (1.f / 128.f) + EPS);
            const f32x4 ga = *(const f32x4*)(go + (c0 & 127)), gb = *(const f32x4*)(go + (c0 & 127) + 4);
            u32x4 r4; r4.x = pk_bf16(o[0] * r * ga[0] * silu_f(gt[0]), o[1] * r * ga[1] * silu_f(gt[1])); r4.y = pk_bf16(o[2] * r * ga[2] * silu_f(gt[2]), o[3] * r * ga[3] * silu_f(gt[3]));
            r4.z = pk_bf16(o[4] * r * gb[0] * silu_f(gt[4]), o[5] * r * gb[1] * silu_f(gt[5])); r4.w = pk_bf16(o[6] * r * gb[2] * silu_f(gt[6]), o[7] * r * gb[3] * silu_f(gt[7]));
            *(u32x4*)(OG + (size_t)row * D + c0) = r4;
        }
    }
}

__device__ __forceinline__ void phase_final(const Params& p) {
    const int tid = opaque_tid(), w = tid >> 6, lane = tid & 63;
    const int gw = blockIdx.x * 8 + w, NGW = gridDim.x * 8;
    const bf16_t* xbf = (const bf16_t*)(p.ws + A_XB); const float* ssq = (const float*)(p.ws + A_SSQ) + (size_t)8 * MT * 32; const float* gf = p.in[6];
    for (int row = gw; row < MT; row += NGW) {
        const float rs = rs_of(ssq, row); float* dst = p.out + (size_t)row * D;
#pragma unroll
        for (int j = 0; j < 4; ++j) { const int c = 4 * lane + 256 * j; const u32x2 xo = *(const u32x2*)(xbf + (size_t)row * D + c);
            *(f32x4*)(dst + c) = (f32x4){bf_lo(xo.x), bf_hi(xo.x), bf_lo(xo.y), bf_hi(xo.y)} * rs * *(const f32x4*)(gf + c); }
    }
}

#define XB_TMO      128
#define XB_XCNT(j)  (256  + 64 * (j))
#define XB_XSUB(j)  (1280 + 64 * (j))
#define XB_XGEN(j)  (2304 + 64 * (j))
#define XB_TOP      3328
#define XB_TOPGEN   3392
#define XCD_BAR_WORDS 3456
#define XB_SPIN_CAP (1u << 20)
__device__ __forceinline__ unsigned xb_ld(unsigned* p)              { return __hip_atomic_load(p, __ATOMIC_RELAXED, __HIP_MEMORY_SCOPE_AGENT); }
__device__ __forceinline__ unsigned xb_add(unsigned* p, unsigned v) { return __hip_atomic_fetch_add(p, v, __ATOMIC_RELAXED, __HIP_MEMORY_SCOPE_AGENT); }
__device__ __forceinline__ unsigned xb_xcc_id() { return (unsigned)__builtin_amdgcn_s_getreg((3 << 11) | 20) & 0xFu; }
#define XB_SPIN(cond, bar) do { unsigned _sp = 0; while (cond) { __builtin_amdgcn_s_sleep(1); \
    if ((++_sp & 255u) == 0u) { if (xb_ld(&(bar)[XB_TMO])) break; if (_sp > XB_SPIN_CAP) { atomicAdd(&(bar)[XB_TMO], 1u); break; } } } } while (0)
struct XcdBarrier { unsigned* bar; unsigned x; volatile LAS unsigned* st; };
__device__ __forceinline__ XcdBarrier xcd_barrier_post(unsigned* bar, volatile LAS unsigned* st) {
    XcdBarrier b; b.bar = bar; b.x = xb_xcc_id(); b.st = st;
    if (threadIdx.x == 0) (void)xb_add(&bar[XB_XCNT(b.x)], 1u);
    return b;
}
__device__ __forceinline__ void xcd_barrier_complete(unsigned* bar, unsigned x, unsigned& nloc, unsigned& nx) {
    const unsigned G = gridDim.x * gridDim.y * gridDim.z;
    unsigned sum, cnt, mine, sp = 0u;
    for (;;) {
        sum = 0u; cnt = 0u; mine = 0u;
#pragma unroll
        for (unsigned j = 0; j < 16; ++j) { const unsigned c = xb_ld(&bar[XB_XCNT(j)]); sum += c; cnt += (c > 0u) ? 1u : 0u; mine = (j == x) ? c : mine; }
        if (sum == G) break;
        __builtin_amdgcn_s_sleep(1);
        if ((++sp & 255u) == 0u) { if (xb_ld(&bar[XB_TMO])) break; if (sp > XB_SPIN_CAP) { atomicAdd(&bar[XB_TMO], 1u); break; } }
    }
    nloc = mine > 0u ? mine : 1u; nx = cnt > 0u ? cnt : 1u;
}
__device__ __forceinline__ void xcd_barrier(const XcdBarrier& b) {
    asm volatile("s_waitcnt vmcnt(0)" ::: "memory");
    __syncthreads();
    if (threadIdx.x == 0) {
        unsigned* bar = b.bar;
        __builtin_amdgcn_s_waitcnt(0);
        unsigned nloc = b.st[0], nx = b.st[1];
        if (nloc == 0u) { xcd_barrier_complete(bar, b.x, nloc, nx); b.st[0] = nloc; b.st[1] = nx; }
        const unsigned old = xb_add(&bar[XB_XSUB(b.x)], 1u);
        const unsigned gen = old / nloc;
        if (old + 1u == (gen + 1u) * nloc) {
            __builtin_amdgcn_fence(__ATOMIC_RELEASE, "agent");
            asm volatile("s_waitcnt vmcnt(0)" ::: "memory");
            const unsigned og = xb_add(&bar[XB_TOP], 1u);
            const unsigned tg = og / nx;
            if (og + 1u == (tg + 1u) * nx) xb_add(&bar[XB_TOPGEN], 1u);
            else XB_SPIN(xb_ld(&bar[XB_TOPGEN]) == tg, bar);
            __builtin_amdgcn_fence(__ATOMIC_ACQUIRE, "agent");
            xb_add(&bar[XB_XGEN(b.x)], 1u);
            asm volatile("s_waitcnt vmcnt(0)" ::: "memory");
        } else {
            XB_SPIN(xb_ld(&bar[XB_XGEN(b.x)]) == gen, bar);
            __builtin_amdgcn_fence(__ATOMIC_ACQUIRE, "agent");
            asm volatile("s_waitcnt vmcnt(0)" ::: "memory");
        }
    }
    __syncthreads();
}

__global__ void __launch_bounds__(512) fwd_kernel(Params p) {
    extern __shared__ __attribute__((aligned(16))) unsigned char shm[];
    cg::grid_group grid = cg::this_grid();
    LAS unsigned char* lds = (LAS unsigned char*)shm;
    unsigned char* ws = p.ws;
    const int G = gridDim.x, c = blockIdx.x;
    bf16_t* xb = (bf16_t*)(ws + A_XB); float* xres = (float*)(ws + A_XRES); float* ssqb = (float*)(ws + A_SSQ);
    volatile LAS unsigned* xst = (volatile LAS unsigned*)(lds + 131072);
    float* rsb = (float*)(shm + 131072 + 256);
    if (threadIdx.x == 0) { xst[0] = 0u; xst[1] = 0u; }
    __syncthreads();
    XcdBarrier xbar = xcd_barrier_post((unsigned*)(ws + A_BAR), xst);
    for (int ph = p.ph_lo; ph < p.ph_hi; ++ph) {
        int kind, l;
        if (ph == 0) { kind = 0; l = 0; }
        else if (ph == NPHASE - 1) { kind = 11; l = 0; }
        else { const int q = ph - 1, pr = q / 13, r = q - pr * 13;
            if (r < 5) { l = 2 * pr; kind = 1 + r; } else { l = 2 * pr + 1; const int rr = r - 5; kind = rr < 2 ? 6 + rr : (rr == 2 ? 12 : (rr < 6 ? 5 + rr : (rr == 6 ? 4 : 5))); } }
        const int lj = l >> 1;
        pg8::StaticOrder S;
#ifndef DUP_MASK
#define DUP_MASK 0
#endif
        for (int rep = 0; rep < 1 + ((DUP_MASK >> kind) & 1); ++rep) {
#ifndef KMASK
#define KMASK 0xFFF
#endif
#define KON(x) ((KMASK >> (x)) & 1)
        if (kind == 0) { if (KON(0)) phase_pre(p, shm); }
        else if (kind == 1 && KON(1)) {
            const bf16_t* Wt = (const bf16_t*)(ws + W_AIN) + (size_t)lj * 4096 * 1024; const float* ssq = ssqb + (size_t)(2 * l) * MT * 32;
            S.init(MP, 2048, G, c); load_rs(rsb, ssq, S);
            { pg8::Gemm g{xb, Wt, MP, 2048, 1024}; EpiGeluU E{(bf16_t*)(ws + R_U), rsb}; pg8::gemm_phase<EpiGeluU, false>(lds, g, S, E); }
            { pg8::Gemm g{xb, Wt + (size_t)2048 * 1024, MP, 2048, 1024}; EpiGeluVT E{(bf16_t*)(ws + R_VT), rsb, (float*)(ws + A_VSQ)}; pg8::gemm_phase<EpiGeluVT, true>(lds, g, S, E); }
            { EpiGeluS E{(bf16_t*)(ws + R_U), (float*)(ws + A_VS), ssq}; skinny_gemm(shm, xb + (size_t)MP * D, Wt, 1024, 128, E, G - 1 - c, G); }
        }
        else if (kind == 2) { if (KON(2)) phase_mix(p, lj, shm); }
        else if ((kind == 3 || kind == 10 || kind == 5) && KON(3)) {
            const bf16_t* A; const bf16_t* Wt; int K; int so;
            if (kind == 3) { A = (const bf16_t*)(ws + R_P); Wt = (const bf16_t*)(ws + W_AOUT) + (size_t)lj * 1024 * 2048; K = 2048; so = 2 * l + 1; }
            else if (kind == 10) { A = (const bf16_t*)(ws + R_OG); Wt = (const bf16_t*)(ws + W_BOUT) + (size_t)lj * 1024 * 1024; K = 1024; so = 2 * l + 1; }
            else { A = (const bf16_t*)(ws + R_ACT); Wt = (const bf16_t*)(ws + W_FOUT) + (size_t)l * 1024 * DFF; K = DFF; so = 2 * l + 2; }
            EpiRes E{xb, ssqb + (size_t)so * MT * 32};
            pg8::Gemm g{A, Wt, MP, 1024, K}; S.init(MP, 1024, G, c);
            pg8::gemm_phase<EpiRes, false>(lds, g, S, E);
            skinny_gemm(shm, A + (size_t)MP * K, Wt, K, 32, E, G - 1 - c, G);
        }
        else if (kind == 4 && KON(4)) {
            const bf16_t* Wt = (const bf16_t*)(ws + W_FIN) + (size_t)l * NFIN * 1024;
            EpiSwiglu E{(bf16_t*)(ws + R_ACT), ssqb + (size_t)(2 * l + 1) * MT * 32, rsb};
            pg8::Gemm g{xb, Wt, MP, NFIN, 1024}; S.init(MP, NFIN, G, c); load_rs(rsb, E.ssq, S);
            pg8::gemm_phase<EpiSwiglu, false>(lds, g, S, E);
            if (2 * c >= G) skinny_gemm(shm, xb + (size_t)MP * D, Wt, 1024, 176, E, G - 1 - c, G / 2);
        }
        else if (kind == 6 && KON(6)) {
            const bf16_t* Wt = (const bf16_t*)(ws + W_BIN) + (size_t)lj * 4096 * 1024;
            EpiProj E{(bf16_t*)(ws + R_PROJ), ssqb + (size_t)(2 * l) * MT * 32, rsb};
            pg8::Gemm g{xb, Wt, MP, 4096, 1024}; S.init(MP, 4096, G, c); load_rs(rsb, E.ssq, S);
            pg8::gemm_phase<EpiProj, false>(lds, g, S, E);
            skinny_gemm(shm, xb + (size_t)MP * D, Wt, 1024, 128, E, G - 1 - c, G);
            phase_ba(p, lj, l);
        }
        else if (kind == 7) { if (KON(7)) phase_conv(p, lj); }
        else if (kind == 12) { if (KON(8)) phase_prep(p, lj, shm); }
        else if (kind == 8) { if (KON(8)) phase_scan(p, lj, shm); }
        else if (kind == 9) { if (KON(9)) phase_onorm(p, lj, shm); }
        else if (kind == 11) { if (KON(11)) phase_final(p); }
        }
        if (ph + 1 < p.ph_hi) { if (p.ph_lo < 0) grid.sync();
            xcd_barrier(xbar); }
    }
}

extern "C" void kernel_launch(void* const* d_in, const int* in_sizes, int n_in, void* d_out, int out_size, void* d_ws, size_t ws_size, hipStream_t stream) {
    constexpr int LDS_BYTES = 131072 + 256 + 6144;
    static int grid_blocks = 0;
    if (grid_blocks == 0) {
        if (n_in != 20 || ws_size < WS_END) { fprintf(stderr, "kernel_launch: n_in %d ws %zu (need %zu)\n", n_in, ws_size, (size_t)WS_END); grid_blocks = -1; return; }
        int dev = 0, cus = 0, per_cu = 0;
        hipGetDevice(&dev);
        hipDeviceGetAttribute(&cus, hipDeviceAttributeMultiprocessorCount, dev);
        if (hipFuncSetAttribute((const void*)fwd_kernel, hipFuncAttributeMaxDynamicSharedMemorySize, LDS_BYTES) != hipSuccess) { fprintf(stderr, "kernel_launch: hipFuncSetAttribute failed\n"); grid_blocks = -1; return; }
        hipOccupancyMaxActiveBlocksPerMultiprocessor(&per_cu, (const void*)fwd_kernel, 512, LDS_BYTES);
        if (per_cu < 1) { fprintf(stderr, "kernel_launch: occupancy query says %d\n", per_cu); grid_blocks = -1; return; }
        grid_blocks = cus;
    }
    if (grid_blocks < 0) return;
    Params p{};
    for (int i = 0; i < 20; ++i) p.in[i] = (const float*)d_in[i];
    p.out = (float*)d_out; p.ws = (unsigned char*)d_ws;
    if (hipMemsetAsync((char*)d_ws + A_BAR, 0, 16384, stream) != hipSuccess) { fprintf(stderr, "kernel_launch: memset failed\n"); return; }
#if MULTI_LAUNCH
    for (int ph = 0; ph < NPHASE; ++ph) { p.ph_lo = ph; p.ph_hi = ph + 1; hipLaunchKernelGGL(fwd_kernel, dim3(grid_blocks), dim3(512), LDS_BYTES, stream, p); }
#else
    p.ph_lo = 0; p.ph_hi = NPHASE;
    void* args[] = {&p};
    hipError_t e = hipLaunchCooperativeKernel((const void*)fwd_kernel, dim3(grid_blocks), dim3(512), args, LDS_BYTES, stream);
    if (e != hipSuccess) fprintf(stderr, "cooperative launch failed: %s (grid %d)\n", hipGetErrorString(e), grid_blocks);
#endif
}
```

```cpp
#include <hip/hip_runtime.h>
#include <hip/hip_cooperative_groups.h>
#include <cstdio>
#include <cstdint>
namespace cg = cooperative_groups;

#ifndef MULTI_LAUNCH
#define MULTI_LAUNCH 0
#endif

#define LAS __attribute__((address_space(3)))
typedef unsigned short bf16_t;
typedef short bf16x8 __attribute__((ext_vector_type(8)));
typedef float f32x4 __attribute__((ext_vector_type(4)));
typedef float f32x2 __attribute__((ext_vector_type(2)));
typedef unsigned u32x4 __attribute__((ext_vector_type(4)));
typedef unsigned u32x2 __attribute__((ext_vector_type(2)));

constexpr int D = 1024, MP = 16384, MS = 128, MT = MP + MS;
constexpr int DA = 2048, DFF = 2816, NFIN = 5632, QKV = 3072, BIN = 4112;
constexpr float EPS = 1e-6f;
constexpr int NPHASE = 28;

constexpr size_t al(size_t x) { return (x + 255) & ~(size_t)255; }
constexpr size_t W_AIN = 0;
constexpr size_t W_AOUT = W_AIN + 2ull * 4096 * 1024 * 2;
constexpr size_t W_BIN = W_AOUT + 2ull * 1024 * 2048 * 2;
constexpr size_t W_BA = W_BIN + 2ull * 4096 * 1024 * 2;
constexpr size_t W_BOUT = W_BA + 2ull * 16 * 1024 * 2;
constexpr size_t W_FIN = W_BOUT + 2ull * 1024 * 1024 * 2;
constexpr size_t W_FOUT = W_FIN + 4ull * 5632 * 1024 * 2;
constexpr size_t A_XRES = W_FOUT + 4ull * 1024 * 2816 * 2;
constexpr size_t A_XB = A_XRES;
constexpr size_t A_SSQ = A_XB + (size_t)MT * 1024 * 2;
constexpr size_t A_BA = al(A_SSQ + 9ull * MT * 32 * 4);
constexpr size_t A_BE = A_BA + (size_t)MT * 16 * 4;
constexpr size_t A_VS = A_BE + (size_t)MT * 16 * 4;
constexpr size_t A_VSQ = al(A_VS + 128ull * 2048 * 4);
constexpr size_t A_BAR = al(A_VSQ + (size_t)MP * 32 * 4);
constexpr size_t A_R = al(A_BAR + 16384);
constexpr size_t R_U = A_R;
constexpr size_t R_VT = al(R_U + (size_t)MT * 2048 * 2);
constexpr size_t R_P = al(R_VT + 2048ull * 16384 * 2);
constexpr size_t R_AEND = R_P + (size_t)MT * 2048 * 2;
constexpr size_t R_ACT = A_R;
constexpr size_t R_PROJ = A_R;
constexpr size_t R_QN = al(R_PROJ + (size_t)MT * 4096 * 2);
constexpr size_t R_KN = R_QN + (size_t)MT * 1024 * 2;
constexpr size_t R_VV = R_KN + (size_t)MT * 1024 * 2;
constexpr size_t R_OB = R_VV + (size_t)MT * 1024 * 2;
constexpr size_t R_OG = R_OB + (size_t)MP * 1024 * 2;
constexpr size_t R_BEND = R_OG + (size_t)MT * 1024 * 2;
constexpr size_t WS_END = R_AEND > R_BEND ? R_AEND : R_BEND;

constexpr size_t O_YP = 0, O_YS = 16777216, O_DP = O_YS + 131072, O_CP = O_DP + 2097152, O_DS = O_CP + 147456, O_CS = O_DS + 33554432, O_CV = O_CS + 2359296;

struct Params { const float* in[20]; float* out; unsigned char* ws; int ph_lo, ph_hi; };

typedef __bf16 bf16x2_t __attribute__((ext_vector_type(2)));
__device__ __forceinline__ unsigned pk_bf16(float lo, float hi) { const bf16x2_t r = __builtin_convertvector((f32x2){lo, hi}, bf16x2_t); return __builtin_bit_cast(unsigned, r); }
__device__ __forceinline__ float bf_lo(unsigned w) { return __uint_as_float(w << 16); }
__device__ __forceinline__ float bf_hi(unsigned w) { return __uint_as_float(w & 0xffff0000u); }
__device__ __forceinline__ float gelu_t(float x) { const float y = 1.5957691216057308f * (x + 0.044715f * x * x * x); return x * __builtin_amdgcn_rcpf(1.f + __expf(-y)); }
__device__ __forceinline__ float silu_f(float x) { return x * __builtin_amdgcn_rcpf(1.f + __expf(-x)); }
__device__ __forceinline__ int opaque_tid() { int t = threadIdx.x; asm volatile("" : "+v"(t)); return t; }
__device__ __forceinline__ float wave_sum(float v) {
#pragma unroll
    for (int o = 1; o < 64; o <<= 1) v += __shfl_xor(v, o);
    return v;
}
__device__ __forceinline__ float sum16(float v) {
#pragma unroll
    for (int o = 1; o < 16; o <<= 1) v += __shfl_xor(v, o);
    return v;
}
__device__ __forceinline__ float dpp_sum16(float x) {
    x += __int_as_float(__builtin_amdgcn_update_dpp(0, __float_as_int(x), 0xB1, 0xF, 0xF, false));
    x += __int_as_float(__builtin_amdgcn_update_dpp(0, __float_as_int(x), 0x4E, 0xF, 0xF, false));
    x += __int_as_float(__builtin_amdgcn_update_dpp(0, __float_as_int(x), 0x141, 0xF, 0xF, false));
    x += __int_as_float(__builtin_amdgcn_update_dpp(0, __float_as_int(x), 0x140, 0xF, 0xF, false));
    return x;
}

namespace pg8 {
constexpr int BM = 256, BK = 64, HALF = 128, HTB = HALF * BK * 2, STAGE_BYTES = 8 * HTB, NXCD = 8, WGM = 8;
__host__ __device__ __forceinline__ int lds_byte(int r, int c) { const int st = (r >> 4) * 2 + (c >> 5), rr = r & 15, cc = c & 31, ob = rr * 64 + cc * 2; return st * 1024 + (ob ^ (((ob >> 9) & 1) << 5)); }
__host__ __device__ __forceinline__ void stage_rc(int b, int& R, int& C) { const int st = b / 1024, sb = b % 1024, swz = sb ^ (((sb >> 9) & 1) << 5); R = (st >> 1) * 16 + swz / 64; C = (st & 1) * 32 + (swz % 64) / 2; }
__host__ __device__ __forceinline__ int perm32(int rho) { const int n = rho >> 4, i = rho & 15; return 8 * (i >> 2) + 4 * n + (i & 3); }
struct Unit { int pm, pn; };
struct Gemm { const bf16_t* A; const bf16_t* Bt; int M, N, K; };
struct StaticOrder {
    int nM, nN, nwg, G, c;
    __host__ __device__ void init(int M, int N, int G_, int c_) { nM = M / BM; nN = N / BM; nwg = nM * nN; G = G_; c = c_; }
    __host__ __device__ bool next(int i, Unit& u) const {
        const long L = (long)i * G + c; if (L >= nwg) return false;
        int wgid = (int)L; { const int q = nwg / NXCD, r = nwg % NXCD, xcd = wgid % NXCD, off = wgid / NXCD; wgid = (xcd < r ? xcd * (q + 1) : r * (q + 1) + (xcd - r) * q) + off; }
        const int nig = WGM * nN, gid = wgid / nig, fm = gid * WGM, gsz = (nM - fm) < WGM ? (nM - fm) : WGM;
        u.pm = fm + ((wgid % nig) % gsz); u.pn = (wgid % nig) / gsz; return true;
    }
};
template <class Epi, bool SWAP>
__device__ __forceinline__ void gemm_phase(LAS unsigned char* lds, const Gemm g, const StaticOrder& S, const Epi& E) {
    const int tid = opaque_tid(), wid = __builtin_amdgcn_readfirstlane(tid >> 6), lane = tid & 63, wr = wid >> 2, wc = wid & 3, fr = lane & 15, fq = lane >> 4;
    int K = g.K; asm volatile("" : "+s"(K)); const int nt = K / BK;
    unsigned voffA[2], voffB[2];
#pragma unroll
    for (int i = 0; i < 2; ++i) { int R, C; stage_rc(tid * 16 + i * 8192, R, C); const int Rb = Epi::PERM ? ((R & ~31) + perm32(R & 31)) : R;
        voffA[i] = (unsigned)(R * K + C) * 2u; voffB[i] = (unsigned)(Rb * K + C) * 2u; }
    const size_t kstep = (size_t)(BK * 2);
    const size_t hstep = (size_t)HALF * K * 2;
    const size_t tstep = 2 * hstep;
    const unsigned ldsw = (unsigned)wid * 1024u;
    const int aoff = lds_byte(wr * 64 + fr, fq * 8), boff = lds_byte(wc * 32 + fr, fq * 8);
#define PG8_SA(b, h) (((b) * 2 + (h)) * HTB)
#define PG8_SB(b, h) ((4 + (b) * 2 + (h)) * HTB)
#define PG8_STAGE(bufoff, gbase, voff) do { _Pragma("unroll") for (int _i = 0; _i < 2; ++_i) \
        __builtin_amdgcn_global_load_lds((const unsigned*)((const char*)(gbase) + (voff)[_i]), (LAS unsigned*)(lds + (bufoff) + ldsw + _i * 8192), 16, 0, 0); } while (0)
#define PG8_LDA(dst, b, h) do { _Pragma("unroll") for (int m = 0; m < 4; ++m) _Pragma("unroll") for (int k = 0; k < 2; ++k) dst[m][k] = *(const LAS bf16x8*)(lds + PG8_SA(b, h) + aoff + m * 2048 + k * 1024); } while (0)
#define PG8_LDB(dst, b, h) do { _Pragma("unroll") for (int n = 0; n < 2; ++n) _Pragma("unroll") for (int k = 0; k < 2; ++k) dst[n][k] = *(const LAS bf16x8*)(lds + PG8_SB(b, h) + boff + n * 2048 + k * 1024); } while (0)
#define PG8_MMA(ai, bj, At, Bt) do { __builtin_amdgcn_s_setprio(1); _Pragma("unroll") for (int m = 0; m < 4; ++m) _Pragma("unroll") for (int n = 0; n < 2; ++n) _Pragma("unroll") for (int k = 0; k < 2; ++k) \
        acc[ai][bj][m][n] = SWAP ? __builtin_amdgcn_mfma_f32_16x16x32_bf16(At[m][k], Bt[n][k], acc[ai][bj][m][n], 0, 0, 0) : __builtin_amdgcn_mfma_f32_16x16x32_bf16(Bt[n][k], At[m][k], acc[ai][bj][m][n], 0, 0, 0); __builtin_amdgcn_s_setprio(0); } while (0)
#define PG8_WAIT_V(n) asm volatile("s_waitcnt vmcnt(" #n ")" ::: "memory")
#define PG8_WAIT_L(n) asm volatile("s_waitcnt lgkmcnt(" #n ")" ::: "memory")
#define PG8_BAR __builtin_amdgcn_s_barrier()
#define PG8_SCHED __builtin_amdgcn_sched_barrier(0)
    Unit cur, nxt; int ui = 0;
    if (!S.next(0, cur)) return;
    f32x4 acc[2][2][4][2];
#pragma unroll
    for (int a = 0; a < 2; ++a)
#pragma unroll
        for (int b = 0; b < 2; ++b)
#pragma unroll
            for (int m = 0; m < 4; ++m)
#pragma unroll
                for (int n = 0; n < 2; ++n) acc[a][b][m][n] = (f32x4){0.f, 0.f, 0.f, 0.f};
    bf16x8 At[4][2], B0[2][2], B1[2][2];
    const char* cA = (const char*)g.A + (size_t)cur.pm * tstep; const char* cB = (const char*)g.Bt + (size_t)cur.pn * tstep;
    PG8_STAGE(PG8_SB(0, 0), cB, voffB); PG8_STAGE(PG8_SA(0, 0), cA, voffA); PG8_STAGE(PG8_SB(0, 1), cB + hstep, voffB); PG8_STAGE(PG8_SA(0, 1), cA + hstep, voffA);
    if (wr == 1) PG8_BAR;
    PG8_WAIT_V(4); PG8_BAR;
    PG8_STAGE(PG8_SB(1, 0), cB + kstep, voffB); PG8_STAGE(PG8_SA(1, 0), cA + kstep, voffA); PG8_STAGE(PG8_SB(1, 1), cB + hstep + kstep, voffB);
    PG8_WAIT_V(6); PG8_BAR;
    for (;;) {
        const bool has_next = S.next(ui + 1, nxt);
        const char* nA = has_next ? (const char*)g.A + (size_t)nxt.pm * tstep : cA; const char* nB = has_next ? (const char*)g.Bt + (size_t)nxt.pn * tstep : cB;
        for (int t = 0; t < nt; t += 2) {
            const bool last = (t == nt - 2);
            const char* a1 = cA + (size_t)(t + 1) * kstep;
            const char* a2 = last ? nA : cA + (size_t)(t + 2) * kstep; const char* b2 = last ? nB : cB + (size_t)(t + 2) * kstep;
            const char* a3 = a2 + kstep; const char* b3 = b2 + kstep;
            PG8_LDB(B0, 0, 0); PG8_SCHED; PG8_LDA(At, 0, 0); PG8_STAGE(PG8_SA(1, 1), a1 + hstep, voffA);
            PG8_WAIT_L(8); PG8_BAR; PG8_WAIT_L(0); PG8_MMA(0, 0, At, B0); PG8_BAR; PG8_SCHED;
            PG8_LDB(B1, 0, 1); PG8_STAGE(PG8_SB(0, 0), b2, voffB);
            PG8_BAR; PG8_WAIT_L(0); PG8_MMA(0, 1, At, B1); PG8_BAR;
            PG8_LDA(At, 0, 1); PG8_STAGE(PG8_SA(0, 0), a2, voffA);
            PG8_BAR; PG8_WAIT_L(0); PG8_MMA(1, 0, At, B0); PG8_BAR; PG8_SCHED;
            PG8_STAGE(PG8_SB(0, 1), b2 + hstep, voffB);
            PG8_WAIT_V(6); PG8_BAR; PG8_MMA(1, 1, At, B1); PG8_BAR;
            PG8_LDB(B0, 1, 0); PG8_SCHED; PG8_LDA(At, 1, 0); PG8_STAGE(PG8_SA(0, 1), a2 + hstep, voffA);
            PG8_WAIT_L(8); PG8_BAR; PG8_WAIT_L(0); PG8_MMA(0, 0, At, B0); PG8_BAR; PG8_SCHED;
            PG8_LDB(B1, 1, 1); PG8_STAGE(PG8_SB(1, 0), b3, voffB);
            PG8_BAR; PG8_WAIT_L(0); PG8_MMA(0, 1, At, B1); PG8_BAR;
            PG8_LDA(At, 1, 1); PG8_STAGE(PG8_SA(1, 0), a3, voffA);
            PG8_BAR; PG8_WAIT_L(0); PG8_MMA(1, 0, At, B0); PG8_BAR; PG8_SCHED;
            PG8_STAGE(PG8_SB(1, 1), b3 + hstep, voffB);
            PG8_WAIT_V(6); PG8_BAR; PG8_MMA(1, 1, At, B1); PG8_BAR;
        }
        E(acc, cur, ui, wr, wc, fr, fq);
        if (!has_next) break;
#pragma unroll
        for (int a = 0; a < 2; ++a)
#pragma unroll
            for (int b = 0; b < 2; ++b)
#pragma unroll
                for (int m = 0; m < 4; ++m)
#pragma unroll
                    for (int n = 0; n < 2; ++n) acc[a][b][m][n] = (f32x4){0.f, 0.f, 0.f, 0.f};
        cur = nxt; cA = nA; cB = nB; ++ui;
    }
    PG8_WAIT_V(0);
    if (wr == 0) PG8_BAR;
    PG8_BAR;
#undef PG8_SA
#undef PG8_SB
#undef PG8_STAGE
#undef PG8_LDA
#undef PG8_LDB
#undef PG8_MMA
#undef PG8_WAIT_V
#undef PG8_WAIT_L
#undef PG8_BAR
#undef PG8_SCHED
}
}
using pg8::Unit;

__device__ __forceinline__ float rs_of(const float* ssq, int row) {
    const f32x4* q = (const f32x4*)(ssq + (size_t)row * 32); f32x4 a = q[0];
#pragma unroll
    for (int i = 1; i < 8; ++i) a += q[i];
    return rsqrtf(((a[0] + a[1]) + (a[2] + a[3])) * (1.f / 1024.f) + EPS);
}
__device__ __forceinline__ void load_rs(float* rsb, const float* ssq, const pg8::StaticOrder& S) {
    const int tid = opaque_tid(); f32x4 v[6][4];
#pragma unroll
    for (int ui = 0; ui < 6; ++ui) { Unit u; const bool ok = S.next(ui, u); const f32x4* q = (const f32x4*)(ssq + ((size_t)(ok ? u.pm : 0) * 256 + (tid >> 1)) * 32 + (tid & 1) * 16);
#pragma unroll
        for (int i = 0; i < 4; ++i) v[ui][i] = q[i]; }
#pragma unroll
    for (int ui = 0; ui < 6; ++ui) { const f32x4 a = (v[ui][0] + v[ui][1]) + (v[ui][2] + v[ui][3]); float t = (a[0] + a[1]) + (a[2] + a[3]); t += __shfl_xor(t, 1);
        if ((tid & 1) == 0) rsb[ui * 256 + (tid >> 1)] = rsqrtf(t * (1.f / 1024.f) + EPS); }
    __syncthreads();
}

struct EpiGeluU {
    static constexpr bool PERM = true;
    bf16_t* U; const float* rsb;
    __device__ __forceinline__ void operator()(const f32x4 (&acc)[2][2][4][2], const Unit& u, int ui, int wr, int wc, int fr, int fq) const {
        float rsv[2][4];
#pragma unroll
        for (int ai = 0; ai < 2; ++ai)
#pragma unroll
            for (int m = 0; m < 4; ++m) rsv[ai][m] = rsb[ui * 256 + ai * 128 + wr * 64 + m * 16 + fr];
#pragma unroll
        for (int ai = 0; ai < 2; ++ai)
#pragma unroll
            for (int m = 0; m < 4; ++m) {
                const int row = u.pm * 256 + ai * 128 + wr * 64 + m * 16 + fr; const float rs = rsv[ai][m];
#pragma unroll
                for (int bj = 0; bj < 2; ++bj) {
                    const int col = u.pn * 256 + bj * 128 + wc * 32 + 8 * fq;
                    const f32x4 a = acc[ai][bj][m][0] * rs, b = acc[ai][bj][m][1] * rs;
                    u32x4 w; w.x = pk_bf16(gelu_t(a[0]), gelu_t(a[1])); w.y = pk_bf16(gelu_t(a[2]), gelu_t(a[3])); w.z = pk_bf16(gelu_t(b[0]), gelu_t(b[1])); w.w = pk_bf16(gelu_t(b[2]), gelu_t(b[3]));
                    *(u32x4*)(U + (size_t)row * DA + col) = w; } }
    }
};
struct EpiGeluVT {
    static constexpr bool PERM = false;
    bf16_t* VT; const float* rsb; float* vsq;
    __device__ __forceinline__ void operator()(const f32x4 (&acc)[2][2][4][2], const Unit& u, int ui, int wr, int wc, int fr, int fq) const {
        f32x4 sv[2][4];
#pragma unroll
        for (int ai = 0; ai < 2; ++ai)
#pragma unroll
            for (int m = 0; m < 4; ++m) sv[ai][m] = *(const f32x4*)(rsb + ui * 256 + ai * 128 + wr * 64 + m * 16 + 4 * fq);
#pragma unroll
        for (int ai = 0; ai < 2; ++ai)
#pragma unroll
            for (int m = 0; m < 4; ++m) {
                const int row0 = u.pm * 256 + ai * 128 + wr * 64 + m * 16 + 4 * fq;
                const f32x4 r4 = sv[ai][m]; f32x4 ss = (f32x4){0.f, 0.f, 0.f, 0.f};
#pragma unroll
                for (int bj = 0; bj < 2; ++bj)
#pragma unroll
                    for (int n = 0; n < 2; ++n) {
                        const int col = u.pn * 256 + bj * 128 + wc * 32 + n * 16 + fr;
                        const f32x4 a = acc[ai][bj][m][n] * r4;
                        const f32x4 gq = (f32x4){gelu_t(a[0]), gelu_t(a[1]), gelu_t(a[2]), gelu_t(a[3])}; ss += gq * gq;
                        u32x2 w; w.x = pk_bf16(gq[0], gq[1]); w.y = pk_bf16(gq[2], gq[3]);
                        *(u32x2*)(VT + (size_t)col * MP + row0) = w; }
                ss[0] = dpp_sum16(ss[0]); ss[1] = dpp_sum16(ss[1]); ss[2] = dpp_sum16(ss[2]); ss[3] = dpp_sum16(ss[3]);
                if (fr == 0) {
#pragma unroll
                    for (int r = 0; r < 4; ++r) vsq[(size_t)(row0 + r) * 32 + u.pn * 4 + wc] = ss[r]; } }
    }
};
struct EpiGeluS {
    bf16_t* U; float* VS; const float* ssq;
    __device__ __forceinline__ int brow(int tau, int n) const { return 32 * tau + 16 * n; }
    __device__ __forceinline__ void sk(int row, int tau, int fq, const f32x4 v0, const f32x4 v1) const {
        const float rs = rs_of(ssq, row);
#pragma unroll
        for (int n = 0; n < 2; ++n) {
            const f32x4 a = (n ? v1 : v0) * rs; const int c = 32 * tau + 16 * n + 4 * fq;
            f32x4 gq; gq[0] = gelu_t(a[0]); gq[1] = gelu_t(a[1]); gq[2] = gelu_t(a[2]); gq[3] = gelu_t(a[3]);
            if (c < DA) { u32x2 w; w.x = pk_bf16(gq[0], gq[1]); w.y = pk_bf16(gq[2], gq[3]); *(u32x2*)(U + (size_t)row * DA + c) = w; }
            else *(f32x4*)(VS + (size_t)(row - MP) * DA + (c - DA)) = gq; }
    }
};
struct EpiSwiglu {
    static constexpr bool PERM = true;
    bf16_t* ACT; const float* ssq; const float* rsb;
    __device__ __forceinline__ void operator()(const f32x4 (&acc)[2][2][4][2], const Unit& u, int ui, int wr, int wc, int fr, int fq) const {
        float rsv[2][4];
#pragma unroll
        for (int ai = 0; ai < 2; ++ai)
#pragma unroll
            for (int m = 0; m < 4; ++m) rsv[ai][m] = rsb[ui * 256 + ai * 128 + wr * 64 + m * 16 + fr];
#pragma unroll
        for (int ai = 0; ai < 2; ++ai)
#pragma unroll
            for (int m = 0; m < 4; ++m) {
                const int row = u.pm * 256 + ai * 128 + wr * 64 + m * 16 + fr; const float rs = rsv[ai][m];
                const int f = u.pn * 128 + wc * 32 + 8 * fq;
                const f32x4 g0 = acc[ai][0][m][0] * rs, g1 = acc[ai][0][m][1] * rs, u0 = acc[ai][1][m][0] * rs, u1 = acc[ai][1][m][1] * rs;
                u32x4 w; w.x = pk_bf16(silu_f(g0[0]) * u0[0], silu_f(g0[1]) * u0[1]); w.y = pk_bf16(silu_f(g0[2]) * u0[2], silu_f(g0[3]) * u0[3]);
                w.z = pk_bf16(silu_f(g1[0]) * u1[0], silu_f(g1[1]) * u1[1]); w.w = pk_bf16(silu_f(g1[2]) * u1[2], silu_f(g1[3]) * u1[3]);
                *(u32x4*)(ACT + (size_t)row * DFF + f) = w; }
    }
    __device__ __forceinline__ int brow(int tau, int n) const { return 256 * (tau >> 3) + 16 * (tau & 7) + 128 * n; }
    __device__ __forceinline__ void sk(int row, int tau, int fq, const f32x4 v0, const f32x4 v1) const {
        const float rs = rs_of(ssq, row); const int f = 128 * (tau >> 3) + 16 * (tau & 7) + 4 * fq;
        const f32x4 g0 = v0 * rs, u0 = v1 * rs;
        u32x2 w; w.x = pk_bf16(silu_f(g0[0]) * u0[0], silu_f(g0[1]) * u0[1]); w.y = pk_bf16(silu_f(g0[2]) * u0[2], silu_f(g0[3]) * u0[3]);
        *(u32x2*)(ACT + (size_t)row * DFF + f) = w;
    }
};
struct EpiProj {
    static constexpr bool PERM = true;
    bf16_t* PROJ; const float* ssq; const float* rsb;
    __device__ __forceinline__ void operator()(const f32x4 (&acc)[2][2][4][2], const Unit& u, int ui, int wr, int wc, int fr, int fq) const {
        float rsv[2][4];
#pragma unroll
        for (int ai = 0; ai < 2; ++ai)
#pragma unroll
            for (int m = 0; m < 4; ++m) rsv[ai][m] = rsb[ui * 256 + ai * 128 + wr * 64 + m * 16 + fr];
#pragma unroll
        for (int ai = 0; ai < 2; ++ai)
#pragma unroll
            for (int m = 0; m < 4; ++m) {
                const int row = u.pm * 256 + ai * 128 + wr * 64 + m * 16 + fr; const float rs = rsv[ai][m];
#pragma unroll
                for (int bj = 0; bj < 2; ++bj) {
                    const int col = u.pn * 256 + bj * 128 + wc * 32 + 8 * fq;
                    const f32x4 a = acc[ai][bj][m][0] * rs, b = acc[ai][bj][m][1] * rs;
                    u32x4 w; w.x = pk_bf16(a[0], a[1]); w.y = pk_bf16(a[2], a[3]); w.z = pk_bf16(b[0], b[1]); w.w = pk_bf16(b[2], b[3]);
                    *(u32x4*)(PROJ + (size_t)row * 4096 + col) = w; } }
    }
    __device__ __forceinline__ int brow(int tau, int n) const { return 32 * tau + 16 * n; }
    __device__ __forceinline__ void sk(int row, int tau, int fq, const f32x4 v0, const f32x4 v1) const {
        const float rs = rs_of(ssq, row);
#pragma unroll
        for (int n = 0; n < 2; ++n) { const f32x4 a = (n ? v1 : v0) * rs; u32x2 w; w.x = pk_bf16(a[0], a[1]); w.y = pk_bf16(a[2], a[3]);
            *(u32x2*)(PROJ + (size_t)row * 4096 + 32 * tau + 16 * n + 4 * fq) = w; }
    }
};
struct EpiRes {
    static constexpr bool PERM = true;
    bf16_t* xb; float* ssq_out;
    __device__ __forceinline__ void operator()(const f32x4 (&acc)[2][2][4][2], const Unit& u, int ui, int wr, int wc, int fr, int fq) const {
#pragma unroll
        for (int ai = 0; ai < 2; ++ai) {
            u32x4 xv[4][2];
#pragma unroll
            for (int m = 0; m < 4; ++m)
#pragma unroll
                for (int bj = 0; bj < 2; ++bj) xv[m][bj] = *(const u32x4*)(xb + (size_t)(u.pm * 256 + ai * 128 + wr * 64 + m * 16 + fr) * D + u.pn * 256 + bj * 128 + wc * 32 + 8 * fq);
#pragma unroll
            for (int m = 0; m < 4; ++m) {
                const int row = u.pm * 256 + ai * 128 + wr * 64 + m * 16 + fr; f32x2 ss = (f32x2){0.f, 0.f};
#pragma unroll
                for (int bj = 0; bj < 2; ++bj) {
                    const size_t o = (size_t)row * D + u.pn * 256 + bj * 128 + wc * 32 + 8 * fq;
                    const u32x4 xo = xv[m][bj];
                    const f32x4 x0 = (f32x4){bf_lo(xo.x), bf_hi(xo.x), bf_lo(xo.y), bf_hi(xo.y)} + acc[ai][bj][m][0];
                    const f32x4 x1 = (f32x4){bf_lo(xo.z), bf_hi(xo.z), bf_lo(xo.w), bf_hi(xo.w)} + acc[ai][bj][m][1];
                    u32x4 w; w.x = pk_bf16(x0[0], x0[1]); w.y = pk_bf16(x0[2], x0[3]); w.z = pk_bf16(x1[0], x1[1]); w.w = pk_bf16(x1[2], x1[3]); *(u32x4*)(xb + o) = w;
                    ss[bj] += ((x0[0] * x0[0] + x0[1] * x0[1]) + (x0[2] * x0[2] + x0[3] * x0[3])) + ((x1[0] * x1[0] + x1[1] * x1[1]) + (x1[2] * x1[2] + x1[3] * x1[3])); }
                ss[0] += __shfl_xor(ss[0], 16); ss[1] += __shfl_xor(ss[1], 16); ss[0] += __shfl_xor(ss[0], 32); ss[1] += __shfl_xor(ss[1], 32);
                if (fq == 0) *(f32x2*)(ssq_out + (size_t)row * 32 + (u.pn * 4 + wc) * 2) = ss; }
            asm volatile("" ::: "memory"); }
    }
    __device__ __forceinline__ int brow(int tau, int n) const { return 32 * tau + 16 * n; }
    __device__ __forceinline__ void sk(int row, int tau, int fq, const f32x4 v0, const f32x4 v1) const {
        float ss = 0.f;
#pragma unroll
        for (int n = 0; n < 2; ++n) {
            const int c = 32 * tau + 16 * n + 4 * fq; const size_t o = (size_t)row * D + c;
            const u32x2 xo = *(const u32x2*)(xb + o);
            const f32x4 x = (f32x4){bf_lo(xo.x), bf_hi(xo.x), bf_lo(xo.y), bf_hi(xo.y)} + (n ? v1 : v0);
            u32x2 w; w.x = pk_bf16(x[0], x[1]); w.y = pk_bf16(x[2], x[3]); *(u32x2*)(xb + o) = w;
            ss += (x[0] * x[0] + x[1] * x[1]) + (x[2] * x[2] + x[3] * x[3]); }
        ss += __shfl_xor(ss, 16); ss += __shfl_xor(ss, 32);
        if (fq == 0) ssq_out[(size_t)row * 32 + tau] = ss;
    }
};

template <class Epi>
__device__ __forceinline__ void skinny_gemm(unsigned char* shm, const bf16_t* Xs, const bf16_t* Bt, int K, int ntiles, const Epi& E, int first, int stride) {
    const int tid = opaque_tid(), w = tid >> 6, lane = tid & 63, fr = lane & 15, fq = lane >> 4;
    const int kper = K >> 3, kbeg = w * kper;
    f32x4* red = (f32x4*)shm;
    for (int tau = first; tau < ntiles; tau += stride) {
        f32x4 acc[8][2];
#pragma unroll
        for (int m = 0; m < 8; ++m) { acc[m][0] = (f32x4){0.f, 0.f, 0.f, 0.f}; acc[m][1] = (f32x4){0.f, 0.f, 0.f, 0.f}; }
        const bf16_t* bp0 = Bt + (size_t)(E.brow(tau, 0) + fr) * K + kbeg + 8 * fq;
        const bf16_t* bp1 = Bt + (size_t)(E.brow(tau, 1) + fr) * K + kbeg + 8 * fq;
        const bf16_t* ap = Xs + (size_t)fr * K + kbeg + 8 * fq;
        for (int k = 0; k < kper; k += 32) {
            const bf16x8 b0 = *(const bf16x8*)(bp0 + k), b1 = *(const bf16x8*)(bp1 + k);
            bf16x8 a[8];
#pragma unroll
            for (int m = 0; m < 8; ++m) a[m] = *(const bf16x8*)(ap + (size_t)m * 16 * K + k);
#pragma unroll
            for (int m = 0; m < 8; ++m) { acc[m][0] = __builtin_amdgcn_mfma_f32_16x16x32_bf16(b0, a[m], acc[m][0], 0, 0, 0); acc[m][1] = __builtin_amdgcn_mfma_f32_16x16x32_bf16(b1, a[m], acc[m][1], 0, 0, 0); }
        }
#pragma unroll
        for (int m = 0; m < 8; ++m) { red[(w * 16 + m * 2 + 0) * 64 + lane] = acc[m][0]; red[(w * 16 + m * 2 + 1) * 64 + lane] = acc[m][1]; }
        __syncthreads();
        f32x4 v0 = (f32x4){0.f, 0.f, 0.f, 0.f}, v1 = v0;
#pragma unroll
        for (int w2 = 0; w2 < 8; ++w2) { v0 += red[(w2 * 16 + w * 2 + 0) * 64 + lane]; v1 += red[(w2 * 16 + w * 2 + 1) * 64 + lane]; }
        __syncthreads();
        E.sk(MP + 16 * w + fr, tau, fq, v0, v1);
    }
}

__device__ __forceinline__ void transpose_tile(const float* W, int ldw, int k0, int nsrc0, const float* gain, bf16_t* dst, int K, int ndst0, bf16_t* scr, int lane) {
#pragma unroll 4
    for (int i = 0; i < 16; ++i) {
        const int k = 4 * i + (lane >> 4), n4 = (lane & 15) * 4;
        const f32x4 v = *(const f32x4*)(W + (size_t)(k0 + k) * ldw + nsrc0 + n4);
        const float gk = gain ? gain[k0 + k] : 1.f;
        const unsigned p0 = pk_bf16(v[0] * gk, v[1] * gk), p1 = pk_bf16(v[2] * gk, v[3] * gk);
        scr[(n4 + 0) * 72 + k] = (bf16_t)(p0 & 0xffffu); scr[(n4 + 1) * 72 + k] = (bf16_t)(p0 >> 16);
        scr[(n4 + 2) * 72 + k] = (bf16_t)(p1 & 0xffffu); scr[(n4 + 3) * 72 + k] = (bf16_t)(p1 >> 16);
    }
    asm volatile("s_waitcnt lgkmcnt(0)" ::: "memory");
#pragma unroll
    for (int j = 0; j < 8; ++j) { const int n = (lane >> 3) + 8 * j, c = lane & 7;
        const u32x4 o = *(const u32x4*)(scr + n * 72 + 8 * c); *(u32x4*)(dst + (size_t)(ndst0 + n) * K + k0 + 8 * c) = o; }
    asm volatile("s_waitcnt lgkmcnt(0)" ::: "memory");
}
__device__ __forceinline__ void phase_pre(const Params& p, unsigned char* shm) {
    const int tid = opaque_tid(), w = tid >> 6, lane = tid & 63;
    const int gw = blockIdx.x * 8 + w, NGW = gridDim.x * 8, gt = blockIdx.x * 512 + tid, NGT = gridDim.x * 512;
    unsigned char* ws = p.ws;
    float* ssq = (float*)(ws + A_SSQ);
    bf16_t* xb = (bf16_t*)(ws + A_XB);
    for (int row = gw; row < MT; row += NGW) {
        const float* src = row < MP ? p.in[0] + (size_t)row * D : p.in[1] + (size_t)(row - MP) * D;
        float ss = 0.f;
#pragma unroll
        for (int j = 0; j < 4; ++j) { const f32x4 v = *(const f32x4*)(src + 4 * lane + 256 * j); ss += (v[0] * v[0] + v[1] * v[1]) + (v[2] * v[2] + v[3] * v[3]);
            u32x2 o; o.x = pk_bf16(v[0], v[1]); o.y = pk_bf16(v[2], v[3]); *(u32x2*)(xb + (size_t)row * D + 4 * lane + 256 * j) = o; }
        ss = wave_sum(ss);
        if (lane < 32) ssq[(size_t)row * 32 + lane] = lane == 0 ? ss : 0.f;
    }
    bf16_t* wba = (bf16_t*)(ws + W_BA);
    for (int i = gt; i < 2 * 16 * 1024; i += NGT) { const int j = i >> 14, n = (i >> 10) & 15, k = i & 1023;
        const float v = p.in[12][((size_t)j * 1024 + k) * BIN + 4096 + n] * p.in[4][(2 * j + 1) * 1024 + k];
        wba[i] = (bf16_t)(pk_bf16(v, 0.f) & 0xffffu); }
    bf16_t* scr = (bf16_t*)(shm + w * 9216);
    for (int it = gw; it < 14080; it += NGW) {
        int r = it;
        if (r < 2048) { const int j = r >> 10; r &= 1023; const int kt = r >> 6, nt = r & 63;
            transpose_tile(p.in[7] + (size_t)j * 1024 * 4096, 4096, kt * 64, nt * 64, p.in[4] + (2 * j) * 1024, (bf16_t*)(ws + W_AIN) + (size_t)j * 4096 * 1024, 1024, nt * 64, scr, lane); continue; }
        r -= 2048;
        if (r < 1024) { const int j = r >> 9; r &= 511; const int kt = r >> 4, nt = r & 15;
            transpose_tile(p.in[11] + (size_t)j * 2048 * 1024, 1024, kt * 64, nt * 64, nullptr, (bf16_t*)(ws + W_AOUT) + (size_t)j * 1024 * 2048, 2048, nt * 64, scr, lane); continue; }
        r -= 1024;
        if (r < 2048) { const int j = r >> 10; r &= 1023; const int kt = r >> 6, nt = r & 63;
            transpose_tile(p.in[12] + (size_t)j * 1024 * BIN, BIN, kt * 64, nt * 64, p.in[4] + (2 * j + 1) * 1024, (bf16_t*)(ws + W_BIN) + (size_t)j * 4096 * 1024, 1024, nt * 64, scr, lane); continue; }
        r -= 2048;
        if (r < 512) { const int j = r >> 8; r &= 255; const int kt = r >> 4, nt = r & 15;
            transpose_tile(p.in[17] + (size_t)j * 1024 * 1024, 1024, kt * 64, nt * 64, nullptr, (bf16_t*)(ws + W_BOUT) + (size_t)j * 1024 * 1024, 1024, nt * 64, scr, lane); continue; }
        r -= 512;
        if (r < 5632) { const int l = r / 1408; r -= l * 1408; const int kt = r / 88, nt = r - kt * 88; const int nd = nt * 64, pn = nd >> 8, hh = (nd >> 7) & 1, ii = nd & 127;
            transpose_tile(p.in[18] + (size_t)l * 1024 * NFIN, NFIN, kt * 64, hh * DFF + 128 * pn + ii, p.in[5] + l * 1024, (bf16_t*)(ws + W_FIN) + (size_t)l * NFIN * 1024, 1024, nd, scr, lane); continue; }
        r -= 5632;
        { const int l = r / 704; r -= l * 704; const int kt = r >> 4, nt = r & 15;
            transpose_tile(p.in[19] + (size_t)l * DFF * 1024, 1024, kt * 64, nt * 64, nullptr, (bf16_t*)(ws + W_FOUT) + (size_t)l * 1024 * DFF, DFF, nt * 64, scr, lane); }
    }
}

__device__ __forceinline__ void phase_mix(const Params& p, int j, unsigned char* shm) {
    const int tid = opaque_tid(), w = tid >> 6, lane = tid & 63, fr = lane & 15, fq = lane >> 4;
    unsigned char* ws = p.ws;
    const bf16_t* VT = (const bf16_t*)(ws + R_VT); const bf16_t* U = (const bf16_t*)(ws + R_U); bf16_t* P = (bf16_t*)(ws + R_P);
    const float* Wsp = p.in[9] + (size_t)j * 8 * 128 * 128; const float* bsp = p.in[10] + j * 8 * 128; const float* gv = p.in[8] + j * DA;
    float* sred = (float*)shm; float* rvs = (float*)(shm + 16384); bf16_t* Wl = (bf16_t*)(shm + 16384 + 512);
    for (int task = blockIdx.x; task < 256; task += gridDim.x) {
        const int c = task >> 1, hg = task & 1;
        if (tid < 128) { const f32x4* q = (const f32x4*)((const float*)(ws + A_VSQ) + ((size_t)c * 128 + tid) * 32); f32x4 a = q[0];
#pragma unroll
            for (int i = 1; i < 8; ++i) a += q[i];
            rvs[tid] = rsqrtf(((a[0] + a[1]) + (a[2] + a[3])) * (1.f / 2048.f) + EPS); }
        __syncthreads();
        for (int gi = 0; gi < 4; ++gi) {
            const int g = hg * 4 + gi;
            {   const int t = tid >> 2, s0 = (tid & 3) * 32; const float* wrow = Wsp + (size_t)(g * 128 + t) * 128 + s0;
#pragma unroll
                for (int q = 0; q < 8; ++q) { const int s = s0 + 4 * q; f32x4 v = *(const f32x4*)(wrow + 4 * q); const f32x4 r4 = *(const f32x4*)(rvs + s); v = v * r4;
                    v[0] = (s + 0 <= t) ? v[0] : 0.f; v[1] = (s + 1 <= t) ? v[1] : 0.f; v[2] = (s + 2 <= t) ? v[2] : 0.f; v[3] = (s + 3 <= t) ? v[3] : 0.f;
                    u32x2 o; o.x = pk_bf16(v[0], v[1]); o.y = pk_bf16(v[2], v[3]); *(u32x2*)(Wl + t * 136 + s) = o; } }
            __syncthreads();
            f32x4 acc[8][2];
#pragma unroll
            for (int m = 0; m < 8; ++m) { acc[m][0] = (f32x4){0.f, 0.f, 0.f, 0.f}; acc[m][1] = (f32x4){0.f, 0.f, 0.f, 0.f}; }
            const bf16_t* bp = VT + (size_t)(g * 256 + 32 * w + 8 * (fr >> 2) + (fr & 3)) * MP + c * 128 + 8 * fq;
#pragma unroll
            for (int ks = 0; ks < 4; ++ks) {
                const bf16x8 b0 = *(const bf16x8*)(bp + 32 * ks), b1 = *(const bf16x8*)(bp + (size_t)4 * MP + 32 * ks);
#pragma unroll
                for (int m = 0; m < 8; ++m) if (32 * ks <= 16 * m + 15) {
                    const bf16x8 a = *(const bf16x8*)(Wl + (16 * m + fr) * 136 + 32 * ks + 8 * fq);
                    acc[m][0] = __builtin_amdgcn_mfma_f32_16x16x32_bf16(b0, a, acc[m][0], 0, 0, 0); acc[m][1] = __builtin_amdgcn_mfma_f32_16x16x32_bf16(b1, a, acc[m][1], 0, 0, 0); }
            }
#pragma unroll
            for (int m = 0; m < 8; ++m) { const int t = 16 * m + fr; const float bias = bsp[g * 128 + t]; const size_t row = (size_t)c * 128 + t;
                const int col = g * 256 + 32 * w + 8 * fq; const f32x4 ga = *(const f32x4*)(gv + col), gb = *(const f32x4*)(gv + col + 4);
                const u32x4 uu = *(const u32x4*)(U + row * DA + col); const f32x4 m0 = ga * acc[m][0] + bias, m1 = gb * acc[m][1] + bias;
                u32x4 o; o.x = pk_bf16(bf_lo(uu.x) * m0[0], bf_hi(uu.x) * m0[1]); o.y = pk_bf16(bf_lo(uu.y) * m0[2], bf_hi(uu.y) * m0[3]);
                o.z = pk_bf16(bf_lo(uu.z) * m1[0], bf_hi(uu.z) * m1[1]); o.w = pk_bf16(bf_lo(uu.w) * m1[2], bf_hi(uu.w) * m1[3]);
                *(u32x4*)(P + row * DA + col) = o; }
            __syncthreads();
        }
    }
    const int gw = blockIdx.x * 8 + w;
    if (gw < MS) {
        const int b = gw; const float* vs = (const float*)(ws + A_VS) + (size_t)b * DA; float* vout = p.out + O_CV + ((size_t)j * MS + b) * DA;
        f32x4 v[8]; float ss = 0.f;
#pragma unroll
        for (int i = 0; i < 8; ++i) { v[i] = *(const f32x4*)(vs + i * 256 + lane * 4); ss += (v[i][0] * v[i][0] + v[i][1] * v[i][1]) + (v[i][2] * v[i][2] + v[i][3] * v[i][3]); }
        ss = wave_sum(ss); const float rv = rsqrtf(ss * (1.f / 2048.f) + EPS);
#pragma unroll
        for (int i = 0; i < 8; ++i) { const int col = i * 256 + lane * 4; const f32x4 vn = v[i] * rv * *(const f32x4*)(gv + col);
            *(f32x4*)(vout + col) = vn;
            const float w00 = Wsp[(size_t)i * 128 * 128], b0 = bsp[i * 128];
            const f32x4 mx = vn * w00 + b0; const size_t o = (size_t)(MP + b) * DA + col; const u32x2 uu = *(const u32x2*)(U + o);
            u32x2 r; r.x = pk_bf16(bf_lo(uu.x) * mx[0], bf_hi(uu.x) * mx[1]); r.y = pk_bf16(bf_lo(uu.y) * mx[2], bf_hi(uu.y) * mx[3]); *(u32x2*)(P + o) = r; }
    }
}

__device__ __forceinline__ void phase_ba(const Params& p, int lj, int l) {
    const int tid = opaque_tid(), w = tid >> 6, lane = tid & 63, fr = lane & 15, fq = lane >> 4;
    const int gw = blockIdx.x * 8 + w, NGW = gridDim.x * 8;
    unsigned char* ws = p.ws; const bf16_t* xb = (const bf16_t*)(ws + A_XB); const bf16_t* wba = (const bf16_t*)(ws + W_BA) + (size_t)lj * 16 * 1024;
    const float* ssq = (const float*)(ws + A_SSQ) + (size_t)(2 * l) * MT * 32; float* ba = (float*)(ws + A_BA);
    for (int task = w * (int)gridDim.x + (int)blockIdx.x; task < MT / 16; task += NGW) {
        f32x4 acc = (f32x4){0.f, 0.f, 0.f, 0.f};
        const bf16_t* ap = xb + (size_t)(task * 16 + fr) * D + 8 * fq; const bf16_t* bp = wba + (size_t)fr * D + 8 * fq;
#pragma unroll 8
        for (int k = 0; k < D; k += 32) acc = __builtin_amdgcn_mfma_f32_16x16x32_bf16(*(const bf16x8*)(bp + k), *(const bf16x8*)(ap + k), acc, 0, 0, 0);
        const int row = task * 16 + fr; const float rs = rs_of(ssq, row);
        *(f32x4*)(ba + (size_t)row * 16 + 4 * fq) = acc * rs;
    }
}

__device__ __forceinline__ void unpack8(const u32x4 q, float (&o)[8]) { o[0] = bf_lo(q.x); o[1] = bf_hi(q.x); o[2] = bf_lo(q.y); o[3] = bf_hi(q.y); o[4] = bf_lo(q.z); o[5] = bf_hi(q.z); o[6] = bf_lo(q.w); o[7] = bf_hi(q.w); }
__device__ __forceinline__ void phase_conv(const Params& p, int lj) {
    const int tid = opaque_tid(), w = tid >> 6, lane = tid & 63;
    const int gw = blockIdx.x * 8 + w, NGW = gridDim.x * 8;
    unsigned char* ws = p.ws; const bf16_t* PROJ = (const bf16_t*)(ws + R_PROJ);
    bf16_t* QN = (bf16_t*)(ws + R_QN); bf16_t* KN = (bf16_t*)(ws + R_KN); bf16_t* VV = (bf16_t*)(ws + R_VV);
    const float* ba = (const float*)(ws + A_BA); float* be = (float*)(ws + A_BE);
    const float* wconv = p.in[13] + (size_t)lj * 4 * QKV; const float* sconv = p.in[3] + (size_t)lj * MS * 3 * QKV;
    for (int task = gw; task < MP / 8; task += NGW) {
        const int row0 = task * 8, b = row0 >> 11, t0 = row0 & 2047;
#pragma unroll 1
        for (int i = 0; i < 6; ++i) {
            const int c0 = i * 512 + lane * 8;
            f32x4 wa[4], wb[4];
#pragma unroll
            for (int jj = 0; jj < 4; ++jj) { wa[jj] = *(const f32x4*)(wconv + (size_t)jj * QKV + c0); wb[jj] = *(const f32x4*)(wconv + (size_t)jj * QKV + c0 + 4); }
            u32x4 win[3], cur[8];
#pragma unroll
            for (int jj = 0; jj < 3; ++jj) { win[jj] = (u32x4){0u, 0u, 0u, 0u}; if (t0 > 0) win[jj] = *(const u32x4*)(PROJ + (size_t)(row0 - 3 + jj) * 4096 + c0); }
#pragma unroll
            for (int r = 0; r < 8; ++r) cur[r] = *(const u32x4*)(PROJ + (size_t)(row0 + r) * 4096 + c0);
#pragma unroll
            for (int r = 0; r < 8; ++r) {
                const int row = row0 + r, t = t0 + r;
                float a0[8], a1[8], a2[8], a3[8]; unpack8(win[0], a0); unpack8(win[1], a1); unpack8(win[2], a2); unpack8(cur[r], a3);
                if (t >= 2045) { float* oc = p.out + O_CP + (((size_t)lj * 8 + b) * 3 + (t - 2045)) * QKV + c0;
                    *(f32x4*)oc = (f32x4){a3[0], a3[1], a3[2], a3[3]}; *(f32x4*)(oc + 4) = (f32x4){a3[4], a3[5], a3[6], a3[7]}; }
                float y[8];
#pragma unroll
                for (int e = 0; e < 4; ++e) { y[e] = a0[e] * wa[0][e] + a1[e] * wa[1][e] + a2[e] * wa[2][e] + a3[e] * wa[3][e]; y[4 + e] = a0[4 + e] * wb[0][e] + a1[4 + e] * wb[1][e] + a2[4 + e] * wb[2][e] + a3[4 + e] * wb[3][e]; }
                float ss = 0.f;
#pragma unroll
                for (int e = 0; e < 8; ++e) { y[e] = silu_f(y[e]); ss += y[e] * y[e]; }
                float sc = 1.f;
                if (i < 4) { ss = sum16(ss); sc = rsqrtf(ss + EPS); if (i < 2) sc *= 0.08838834764831845f; }
                u32x4 o; o.x = pk_bf16(y[0] * sc, y[1] * sc); o.y = pk_bf16(y[2] * sc, y[3] * sc); o.z = pk_bf16(y[4] * sc, y[5] * sc); o.w = pk_bf16(y[6] * sc, y[7] * sc);
                bf16_t* dst = (i < 2 ? QN : (i < 4 ? KN : VV)) + (size_t)row * D + (c0 & 1023);
                *(u32x4*)dst = o;
                win[0] = win[1]; win[1] = win[2]; win[2] = cur[r];
            }
        }
        {   const int row = row0 + (lane >> 3), hh = lane & 7;
            const float braw = ba[(size_t)row * 16 + hh], araw = ba[(size_t)row * 16 + 8 + hh];
            const float beta = 1.f / (1.f + expf(-braw));
            const float xs = araw + p.in[15][lj * 8 + hh]; const float sp = xs > 20.f ? xs : log1pf(expf(xs));
            const float gg = -expf(p.in[14][lj * 8 + hh]) * sp;
            be[(size_t)row * 16 + hh] = beta; be[(size_t)row * 16 + 8 + hh] = gg; }
    }
    for (int sb = w * (int)gridDim.x + (int)blockIdx.x; sb < MS; sb += NGW) {
        const int b = sb, row = MP + sb;
#pragma unroll 1
        for (int i = 0; i < 6; ++i) {
            const int c0 = i * 512 + lane * 8;
            float raw[4][8];
            unpack8(*(const u32x4*)(PROJ + (size_t)row * 4096 + c0), raw[3]);
#pragma unroll
            for (int jj = 0; jj < 3; ++jj) { const float* sp_ = sconv + ((size_t)b * 3 + jj) * QKV + c0; const f32x4 a = *(const f32x4*)sp_, c = *(const f32x4*)(sp_ + 4);
                raw[jj][0] = a[0]; raw[jj][1] = a[1]; raw[jj][2] = a[2]; raw[jj][3] = a[3]; raw[jj][4] = c[0]; raw[jj][5] = c[1]; raw[jj][6] = c[2]; raw[jj][7] = c[3]; }
            float* oc = p.out + O_CS + ((size_t)lj * MS + b) * 3 * QKV + c0;
#pragma unroll
            for (int jj = 0; jj < 3; ++jj) { const int sj = jj + 1;
                *(f32x4*)(oc + (size_t)jj * QKV) = (f32x4){raw[sj][0], raw[sj][1], raw[sj][2], raw[sj][3]}; *(f32x4*)(oc + (size_t)jj * QKV + 4) = (f32x4){raw[sj][4], raw[sj][5], raw[sj][6], raw[sj][7]}; }
            float y[8];
#pragma unroll
            for (int e = 0; e < 8; ++e) y[e] = 0.f;
#pragma unroll
            for (int jj = 0; jj < 4; ++jj) { const f32x4 wa = *(const f32x4*)(wconv + (size_t)jj * QKV + c0), wb = *(const f32x4*)(wconv + (size_t)jj * QKV + c0 + 4);
                y[0] += raw[jj][0] * wa[0]; y[1] += raw[jj][1] * wa[1]; y[2] += raw[jj][2] * wa[2]; y[3] += raw[jj][3] * wa[3];
                y[4] += raw[jj][4] * wb[0]; y[5] += raw[jj][5] * wb[1]; y[6] += raw[jj][6] * wb[2]; y[7] += raw[jj][7] * wb[3]; }
            float ss = 0.f;
#pragma unroll
            for (int e = 0; e < 8; ++e) { y[e] = silu_f(y[e]); ss += y[e] * y[e]; }
            float sc = 1.f;
            if (i < 4) { ss = sum16(ss); sc = rsqrtf(ss + EPS); if (i < 2) sc *= 0.08838834764831845f; }
            u32x4 o; o.x = pk_bf16(y[0] * sc, y[1] * sc); o.y = pk_bf16(y[2] * sc, y[3] * sc); o.z = pk_bf16(y[4] * sc, y[5] * sc); o.w = pk_bf16(y[6] * sc, y[7] * sc);
            bf16_t* dst = (i < 2 ? QN : (i < 4 ? KN : VV)) + (size_t)row * D + (c0 & 1023);
            *(u32x4*)dst = o;
        }
        if (lane < 8) {
            const float braw = ba[(size_t)row * 16 + lane], araw = ba[(size_t)row * 16 + 8 + lane];
            const float beta = 1.f / (1.f + expf(-braw));
            const float xs = araw + p.in[15][lj * 8 + lane]; const float sp = xs > 20.f ? xs : log1pf(expf(xs));
            const float gg = -expf(p.in[14][lj * 8 + lane]) * sp;
            be[(size_t)row * 16 + lane] = beta; be[(size_t)row * 16 + 8 + lane] = gg;
        }
    }
}

__device__ __forceinline__ void phase_prep(const Params& p, int lj, unsigned char* shm) {
    const int tid = opaque_tid(), w = tid >> 6, lane = tid & 63, fr = lane & 15, fq = lane >> 4;
    const int grp = w >> 2, wl = w & 3, gtid = tid & 255;
    unsigned char* ws = p.ws; bf16_t* QN = (bf16_t*)(ws + R_QN); bf16_t* KN = (bf16_t*)(ws + R_KN); bf16_t* VV = (bf16_t*)(ws + R_VV); bf16_t* PROJ = (bf16_t*)(ws + R_PROJ);
    const float* BE = (const float*)(ws + A_BE); float* EGL = (float*)(ws + A_BA);
    float* Lf = (float*)(shm + grp * 18432); float* gcs = Lf + 64 * 68; float* bts = gcs + 64;
    for (int it = 0; it < 4; ++it) {
        const int task = blockIdx.x * 8 + it * 2 + grp;
        if (task >= 2048) break;
        const int b = task >> 8, h = (task >> 5) & 7, n = task & 31; const size_t r0 = (size_t)b * 2048 + n * 64;
        if (wl == 0) {
            float g = BE[(r0 + lane) * 16 + 8 + h]; const float bt = BE[(r0 + lane) * 16 + h];
#pragma unroll
            for (int o = 1; o < 64; o <<= 1) { const float t = __shfl_up(g, o); if (lane >= o) g += t; }
            gcs[lane] = g; bts[lane] = bt; if (lane == 63) EGL[task] = expf(g);
        }
        __syncthreads();
        {
            const int ib = wl; bf16x8 kf[4], qf[4];
#pragma unroll
            for (int ks = 0; ks < 4; ++ks) { kf[ks] = *(const bf16x8*)(KN + (r0 + 16 * ib + fr) * D + h * 128 + 32 * ks + 8 * fq); qf[ks] = *(const bf16x8*)(QN + (r0 + 16 * ib + fr) * D + h * 128 + 32 * ks + 8 * fq); }
            const int i = 16 * ib + fr; const float gi = gcs[i], bi = bts[i];
            bf16x8 ball[4][4];
#pragma unroll
            for (int jb = 0; jb < 4; ++jb) { const int jl = jb <= ib ? jb : ib;
#pragma unroll
                for (int ks = 0; ks < 4; ++ks) ball[jb][ks] = *(const bf16x8*)(KN + (r0 + 16 * jl + fr) * D + h * 128 + 32 * ks + 8 * fq); }
#pragma unroll
            for (int jb = 0; jb < 4; ++jb) {
                bf16_t* adst = PROJ + (r0 + i) * 4096 + h * 128 + 16 * jb + 4 * fq;
                if (jb > ib) { *(u32x2*)adst = (u32x2){0u, 0u}; continue; }
                f32x4 aK = (f32x4){0.f, 0.f, 0.f, 0.f}, aQ = aK;
#pragma unroll
                for (int ks = 0; ks < 4; ++ks) { const bf16x8 bfr = ball[jb][ks];
                    aK = __builtin_amdgcn_mfma_f32_16x16x32_bf16(bfr, kf[ks], aK, 0, 0, 0); aQ = __builtin_amdgcn_mfma_f32_16x16x32_bf16(bfr, qf[ks], aQ, 0, 0, 0); }
                f32x4 Lv, Av;
#pragma unroll
                for (int r = 0; r < 4; ++r) { const int j = 16 * jb + 4 * fq + r; const float e = (i >= j) ? __expf(gi - gcs[j]) : 0.f; Lv[r] = (i > j) ? bi * aK[r] * e : 0.f; Av[r] = aQ[r] * e; }
                *(f32x4*)(Lf + i * 68 + 16 * jb + 4 * fq) = Lv;
                u32x2 o; o.x = pk_bf16(Av[0], Av[1]); o.y = pk_bf16(Av[2], Av[3]); *(u32x2*)adst = o;
            }
        }
        u32x4 qreg[4];
        { const int row = gtid >> 2, seg = gtid & 3;
#pragma unroll
          for (int e = 0; e < 4; ++e) qreg[e] = *(const u32x4*)(QN + (r0 + row) * D + h * 128 + seg * 32 + 8 * e); }
        float x[64];
        { const bf16_t* src = (wl < 2 ? VV : KN) + r0 * D + h * 128 + (wl & 1) * 64 + lane;
#pragma unroll
          for (int i = 0; i < 64; ++i) x[i] = __uint_as_float((unsigned)src[(size_t)i * D] << 16); }
        asm volatile("s_waitcnt vmcnt(0)" ::: "memory");
        __syncthreads();
        { const int row = gtid >> 2, seg = gtid & 3; const float e = __expf(gcs[row]);
#pragma unroll
          for (int q = 0; q < 4; ++q) { u32x4 o; o.x = pk_bf16(bf_lo(qreg[q].x) * e, bf_hi(qreg[q].x) * e); o.y = pk_bf16(bf_lo(qreg[q].y) * e, bf_hi(qreg[q].y) * e); o.z = pk_bf16(bf_lo(qreg[q].z) * e, bf_hi(qreg[q].z) * e); o.w = pk_bf16(bf_lo(qreg[q].w) * e, bf_hi(qreg[q].w) * e);
              *(u32x4*)(QN + (r0 + row) * D + h * 128 + seg * 32 + 8 * q) = o; } }
        const int col = (wl & 1) * 64 + lane;
        if (wl >= 2) {
            const float gl = gcs[63];
            bf16_t* kd = PROJ + (r0 + (col >> 1)) * 4096 + 1024 + h * 128 + (col & 1) * 64;
#pragma unroll
            for (int c8 = 0; c8 < 8; ++c8) { float t[8];
#pragma unroll
                for (int e = 0; e < 8; ++e) t[e] = x[c8 * 8 + e] * __expf(gl - gcs[c8 * 8 + e]);
                u32x4 o; o.x = pk_bf16(t[0], t[1]); o.y = pk_bf16(t[2], t[3]); o.z = pk_bf16(t[4], t[5]); o.w = pk_bf16(t[6], t[7]); *(u32x4*)(kd + c8 * 8) = o; }
#pragma unroll
            for (int i = 0; i < 64; ++i) x[i] *= bts[i] * __expf(gcs[i]);
        } else {
#pragma unroll
            for (int i = 0; i < 64; ++i) x[i] *= bts[i];
        }
#pragma unroll
        for (int i = 1; i < 64; ++i) {
            float a0 = x[i], a1 = 0.f, a2 = 0.f, a3 = 0.f;
#pragma unroll
            for (int j4 = 0; j4 < i; j4 += 4) { const f32x4 l4 = *(const f32x4*)(Lf + i * 68 + j4);
                a0 -= l4[0] * x[j4]; if (j4 + 1 < i) a1 -= l4[1] * x[j4 + 1]; if (j4 + 2 < i) a2 -= l4[2] * x[j4 + 2]; if (j4 + 3 < i) a3 -= l4[3] * x[j4 + 3]; }
            x[i] = (a0 + a1) + (a2 + a3);
        }
        if (wl < 2) {
            bf16_t* ut = VV + (r0 + (col >> 1)) * D + h * 128 + (col & 1) * 64;
#pragma unroll
            for (int c8 = 0; c8 < 8; ++c8) { u32x4 o; o.x = pk_bf16(x[c8 * 8 + 0], x[c8 * 8 + 1]); o.y = pk_bf16(x[c8 * 8 + 2], x[c8 * 8 + 3]); o.z = pk_bf16(x[c8 * 8 + 4], x[c8 * 8 + 5]); o.w = pk_bf16(x[c8 * 8 + 6], x[c8 * 8 + 7]); *(u32x4*)(ut + c8 * 8) = o; }
        } else {
            bf16_t* wd = KN + r0 * D + h * 128 + col;
#pragma unroll
            for (int i = 0; i < 64; ++i) wd[(size_t)i * D] = (bf16_t)(pk_bf16(x[i], 0.f) & 0xffffu);
        }
        __syncthreads();
    }
}

__device__ __forceinline__ void phase_scan(const Params& p, int lj, unsigned char* shm) {
    const int tid = opaque_tid(), w = tid >> 6, lane = tid & 63, fr = lane & 15, fq = lane >> 4, cb = w & 3, db = w >> 2;
    unsigned char* ws = p.ws; const bf16_t* QN = (const bf16_t*)(ws + R_QN); const bf16_t* KN = (const bf16_t*)(ws + R_KN); const bf16_t* VV = (const bf16_t*)(ws + R_VV); const bf16_t* PROJ = (const bf16_t*)(ws + R_PROJ);
    const float* EGL = (const float*)(ws + A_BA); bf16_t* OB = (bf16_t*)(ws + R_OB);
    bf16_t* ST = (bf16_t*)shm; bf16_t* VN = (bf16_t*)(shm + 8704);
    for (int task = blockIdx.x; task < 256; task += gridDim.x) {
        const int b = task & 7, h = task >> 5, vq = (task >> 3) & 3;
        f32x4 Sacc[2]; Sacc[0] = (f32x4){0.f, 0.f, 0.f, 0.f}; Sacc[1] = Sacc[0];
        for (int i = tid; i < 8704 / 4; i += 512) ((unsigned*)ST)[i] = 0u;
        __syncthreads();
        const int dvg = vq * 32 + 16 * db + fr, dkr = 16 * w + fr;
#define SCAN_BAR() do { asm volatile("s_waitcnt lgkmcnt(0)" ::: "memory"); __builtin_amdgcn_s_barrier(); asm volatile("" ::: "memory"); } while (0)
#define SCAN_LOAD(N_, wf_, qf_, af_, kdf_, ut_, eg_) do { const size_t r0_ = (size_t)b * 2048 + (N_) * 64; \
            _Pragma("unroll") for (int ks = 0; ks < 4; ++ks) { wf_[ks] = *(const bf16x8*)(KN + (r0_ + 16 * cb + fr) * D + h * 128 + 32 * ks + 8 * fq); qf_[ks] = *(const bf16x8*)(QN + (r0_ + 16 * cb + fr) * D + h * 128 + 32 * ks + 8 * fq); } \
            _Pragma("unroll") for (int ks = 0; ks < 2; ++ks) { af_[ks] = *(const bf16x8*)(PROJ + (r0_ + 16 * cb + fr) * 4096 + h * 128 + 32 * ks + 8 * fq); \
                kdf_[ks] = *(const bf16x8*)(PROJ + (r0_ + (dkr >> 1)) * 4096 + 1024 + h * 128 + (dkr & 1) * 64 + 32 * ks + 8 * fq); } \
            ut_ = *(const u32x2*)(VV + (r0_ + (dvg >> 1)) * D + h * 128 + (dvg & 1) * 64 + 16 * cb + 4 * fq); eg_ = EGL[(b * 8 + h) * 32 + (N_)]; } while (0)
        bf16x8 wf[4], qf[4], af[2], kdf[2]; u32x2 utw; float egl;
        SCAN_LOAD(0, wf, qf, af, kdf, utw, egl);
        for (int n = 0; n < 32; ++n) {
            const size_t r0 = (size_t)b * 2048 + n * 64;
            bf16x8 nwf[4], nqf[4], naf[2], nkdf[2], sf[4]; u32x2 nutw; float negl;
            const int nn = n < 31 ? n + 1 : n;
            SCAN_LOAD(nn, nwf, nqf, naf, nkdf, nutw, negl);
#pragma unroll
            for (int ks = 0; ks < 4; ++ks) sf[ks] = *(const bf16x8*)(ST + (16 * db + fr) * 136 + 32 * ks + 8 * fq);
            f32x4 acc = (f32x4){0.f, 0.f, 0.f, 0.f}, oacc = acc;
#pragma unroll
            for (int ks = 0; ks < 4; ++ks) acc = __builtin_amdgcn_mfma_f32_16x16x32_bf16(wf[ks], sf[ks], acc, 0, 0, 0);
            { u32x2 o; o.x = pk_bf16(bf_lo(utw.x) - acc[0], bf_hi(utw.x) - acc[1]); o.y = pk_bf16(bf_lo(utw.y) - acc[2], bf_hi(utw.y) - acc[3]); *(u32x2*)(VN + (16 * db + fr) * 72 + 16 * cb + 4 * fq) = o; }
#pragma unroll
            for (int ks = 0; ks < 4; ++ks) oacc = __builtin_amdgcn_mfma_f32_16x16x32_bf16(sf[ks], qf[ks], oacc, 0, 0, 0);
            SCAN_BAR();
#pragma unroll
            for (int ks = 0; ks < 2; ++ks) { const bf16x8 vnf = *(const bf16x8*)(VN + (16 * db + fr) * 72 + 32 * ks + 8 * fq); oacc = __builtin_amdgcn_mfma_f32_16x16x32_bf16(vnf, af[ks], oacc, 0, 0, 0); }
            { u32x2 o; o.x = pk_bf16(oacc[0], oacc[1]); o.y = pk_bf16(oacc[2], oacc[3]); *(u32x2*)(OB + (r0 + 16 * cb + fr) * D + h * 128 + vq * 32 + 16 * db + 4 * fq) = o; }
#pragma unroll
            for (int dvb = 0; dvb < 2; ++dvb) { Sacc[dvb] = Sacc[dvb] * egl;
#pragma unroll
                for (int ks = 0; ks < 2; ++ks) { const bf16x8 vnd = *(const bf16x8*)(VN + (16 * dvb + fr) * 72 + 32 * ks + 8 * fq); Sacc[dvb] = __builtin_amdgcn_mfma_f32_16x16x32_bf16(kdf[ks], vnd, Sacc[dvb], 0, 0, 0); }
                u32x2 o; o.x = pk_bf16(Sacc[dvb][0], Sacc[dvb][1]); o.y = pk_bf16(Sacc[dvb][2], Sacc[dvb][3]); *(u32x2*)(ST + (16 * dvb + fr) * 136 + 16 * w + 4 * fq) = o; }
            SCAN_BAR();
#pragma unroll
            for (int ks = 0; ks < 4; ++ks) { wf[ks] = nwf[ks]; qf[ks] = nqf[ks]; }
#pragma unroll
            for (int ks = 0; ks < 2; ++ks) { af[ks] = naf[ks]; kdf[ks] = nkdf[ks]; }
            utw = nutw; egl = negl;
        }
#undef SCAN_BAR
#undef SCAN_LOAD
        float* So = p.out + O_DP + (((size_t)lj * 8 + b) * 8 + h) * 16384;
#pragma unroll
        for (int dvb = 0; dvb < 2; ++dvb)
#pragma unroll
            for (int r = 0; r < 4; ++r) So[(size_t)(16 * w + 4 * fq + r) * 128 + vq * 32 + 16 * dvb + fr] = Sacc[dvb][r];
        __syncthreads();
    }
}

__device__ __forceinline__ void phase_onorm(const Params& p, int lj, unsigned char* shm) {
    const int tid = opaque_tid(), w = tid >> 6, lane = tid & 63;
    const int gw = blockIdx.x * 8 + w, NGW = gridDim.x * 8;
    unsigned char* ws = p.ws; const bf16_t* OB = (const bf16_t*)(ws + R_OB); const bf16_t* PROJ = (const bf16_t*)(ws + R_PROJ); bf16_t* OG = (bf16_t*)(ws + R_OG);
    const bf16_t* QN = (const bf16_t*)(ws + R_QN); const bf16_t* KN = (const bf16_t*)(ws + R_KN); const bf16_t* VV = (const bf16_t*)(ws + R_VV);
    const float* BE = (const float*)(ws + A_BE); const float* go = p.in[16] + lj * 128;
    {
        float* pex = (float*)shm; float* oex = pex + 8 * 128;
        const int task = blockIdx.x * 4 + (w >> 1), half = __builtin_amdgcn_readfirstlane(w & 1);
        const bool live = task < MS * 8;
        const int b = live ? task >> 3 : 0, h = task & 7; const size_t row = MP + b;
        const float* S0 = p.in[2] + (((size_t)lj * MS + b) * 8 + h) * 16384 + (size_t)half * 64 * 128; float* S1 = p.out + O_DS + (((size_t)lj * MS + b) * 8 + h) * 16384 + (size_t)half * 64 * 128;
        f32x2 Sr[64];
#pragma unroll
        for (int i = 0; i < 64; ++i) Sr[i] = *(const f32x2*)(S0 + (size_t)i * 128 + 2 * lane);
        const unsigned kw = *(const unsigned*)(KN + row * D + h * 128 + 2 * lane), qw = *(const unsigned*)(QN + row * D + h * 128 + 2 * lane), vw = *(const unsigned*)(VV + row * D + h * 128 + 2 * lane);
        const float ka = bf_lo(kw), kb = bf_hi(kw), qa = bf_lo(qw), qb = bf_hi(qw), va = bf_lo(vw), vb = bf_hi(vw);
        const float beta = BE[row * 16 + h], eg = expf(BE[row * 16 + 8 + h]);
        f32x2 pp = (f32x2){0.f, 0.f};
#pragma unroll
        for (int i2 = 0; i2 < 32; ++i2) {
            const float kv0 = __int_as_float(__builtin_amdgcn_readlane(__float_as_int(ka), 32 * half + i2)), kv1 = __int_as_float(__builtin_amdgcn_readlane(__float_as_int(kb), 32 * half + i2));
            pp += Sr[2 * i2] * kv0 + Sr[2 * i2 + 1] * kv1; }
        *(f32x2*)(pex + w * 128 + 2 * lane) = pp;
        __syncthreads();
        { const f32x2 other = *(const f32x2*)(pex + (w ^ 1) * 128 + 2 * lane); pp += other; }
        const float d0 = beta * (va - eg * pp[0]), d1 = beta * (vb - eg * pp[1]);
        f32x2 oo = (f32x2){0.f, 0.f};
#pragma unroll
        for (int i2 = 0; i2 < 32; ++i2) {
            const float kv0 = __int_as_float(__builtin_amdgcn_readlane(__float_as_int(ka), 32 * half + i2)), kv1 = __int_as_float(__builtin_amdgcn_readlane(__float_as_int(kb), 32 * half + i2));
            const float qv0 = __int_as_float(__builtin_amdgcn_readlane(__float_as_int(qa), 32 * half + i2)), qv1 = __int_as_float(__builtin_amdgcn_readlane(__float_as_int(qb), 32 * half + i2));
            const f32x2 n0 = (f32x2){Sr[2 * i2][0] * eg + kv0 * d0, Sr[2 * i2][1] * eg + kv0 * d1}, n1 = (f32x2){Sr[2 * i2 + 1][0] * eg + kv1 * d0, Sr[2 * i2 + 1][1] * eg + kv1 * d1};
            if (live) { *(f32x2*)(S1 + (size_t)(2 * i2) * 128 + 2 * lane) = n0; *(f32x2*)(S1 + (size_t)(2 * i2 + 1) * 128 + 2 * lane) = n1; }
            oo += n0 * qv0 + n1 * qv1; }
        *(f32x2*)(oex + w * 128 + 2 * lane) = oo;
        __syncthreads();
        { const f32x2 other = *(const f32x2*)(oex + (w ^ 1) * 128 + 2 * lane); oo += other; }
        const float ss = wave_sum(oo[0] * oo[0] + oo[1] * oo[1]); const float r = rsqrtf(ss * (1.f / 128.f) + EPS);
        const unsigned gwd = *(const unsigned*)(PROJ + row * 4096 + QKV + h * 128 + 2 * lane);
        if (live && half == 0) *(unsigned*)(OG + row * D + h * 128 + 2 * lane) = pk_bf16(oo[0] * r * go[2 * lane] * silu_f(bf_lo(gwd)), oo[1] * r * go[2 * lane + 1] * silu_f(bf_hi(gwd)));
    }
    for (int row = gw; row < MP; row += NGW) {
#pragma unroll
        for (int i = 0; i < 2; ++i) {
            const int c0 = i * 512 + lane * 8;
            const u32x4 ow = *(const u32x4*)(OB + (size_t)row * D + c0); const u32x4 gwd = *(const u32x4*)(PROJ + (size_t)row * 4096 + QKV + c0);
            float o[8] = {bf_lo(ow.x), bf_hi(ow.x), bf_lo(ow.y), bf_hi(ow.y), bf_lo(ow.z), bf_hi(ow.z), bf_lo(ow.w), bf_hi(ow.w)};
            float gt[8] = {bf_lo(gwd.x), bf_hi(gwd.x), bf_lo(gwd.y), bf_hi(gwd.y), bf_lo(gwd.z), bf_hi(gwd.z), bf_lo(gwd.w), bf_hi(gwd.w)};
            float ss = 0.f;
#pragma unroll
            for (int e = 0; e < 8; ++e) ss += o[e] * o[e];
            ss = sum16(ss); const float r = rsqrtf(ss * (1.f / 128.f) + EPS);
            const f32x4 ga = *(const f32x4*)(go + (c0 & 127)), gb = *(const f32x4*)(go + (c0 & 127) + 4);
            u32x4 r4; r4.x = pk_bf16(o[0] * r * ga[0] * silu_f(gt[0]), o[1] * r * ga[1] * silu_f(gt[1])); r4.y = pk_bf16(o[2] * r * ga[2] * silu_f(gt[2]), o[3] * r * ga[3] * silu_f(gt[3]));
            r4.z = pk_bf16(o[4] * r * gb[0] * silu_f(gt[4]), o[5] * r * gb[1] * silu_f(gt[5])); r4.w = pk_bf16(o[6] * r * gb[2] * silu_f(gt[6]), o[7] * r * gb[3] * silu_f(gt[7]));
            *(u32x4*)(OG + (size_t)row * D + c0) = r4;
        }
    }
}

__device__ __forceinline__ void phase_final(const Params& p) {
    const int tid = opaque_tid(), w = tid >> 6, lane = tid & 63;
    const int gw = blockIdx.x * 8 + w, NGW = gridDim.x * 8;
    const bf16_t* xbf = (const bf16_t*)(p.ws + A_XB); const float* ssq = (const float*)(p.ws + A_SSQ) + (size_t)8 * MT * 32; const float* gf = p.in[6];
    for (int row = gw; row < MT; row += NGW) {
        const float rs = rs_of(ssq, row); float* dst = p.out + (size_t)row * D;
#pragma unroll
        for (int j = 0; j < 4; ++j) { const int c = 4 * lane + 256 * j; const u32x2 xo = *(const u32x2*)(xbf + (size_t)row * D + c);
            *(f32x4*)(dst + c) = (f32x4){bf_lo(xo.x), bf_hi(xo.x), bf_lo(xo.y), bf_hi(xo.y)} * rs * *(const f32x4*)(gf + c); }
    }
}

#define XB_TMO      128
#define XB_XCNT(j)  (256  + 64 * (j))
#define XB_XSUB(j)  (1280 + 64 * (j))
#define XB_XGEN(j)  (2304 + 64 * (j))
#define XB_TOP      3328
#define XB_TOPGEN   3392
#define XCD_BAR_WORDS 3456
#define XB_SPIN_CAP (1u << 20)
__device__ __forceinline__ unsigned xb_ld(unsigned* p)              { return __hip_atomic_load(p, __ATOMIC_RELAXED, __HIP_MEMORY_SCOPE_AGENT); }
__device__ __forceinline__ unsigned xb_add(unsigned* p, unsigned v) { return __hip_atomic_fetch_add(p, v, __ATOMIC_RELAXED, __HIP_MEMORY_SCOPE_AGENT); }
__device__ __forceinline__ unsigned xb_xcc_id() { return (unsigned)__builtin_amdgcn_s_getreg((3 << 11) | 20) & 0xFu; }
#define XB_SPIN(cond, bar) do { unsigned _sp = 0; while (cond) { __builtin_amdgcn_s_sleep(1); \
    if ((++_sp & 255u) == 0u) { if (xb_ld(&(bar)[XB_TMO])) break; if (_sp > XB_SPIN_CAP) { atomicAdd(&(bar)[XB_TMO], 1u); break; } } } } while (0)
struct XcdBarrier { unsigned* bar; unsigned x; volatile LAS unsigned* st; };
__device__ __forceinline__ XcdBarrier xcd_barrier_post(unsigned* bar, volatile LAS unsigned* st) {
    XcdBarrier b; b.bar = bar; b.x = xb_xcc_id(); b.st = st;
    if (threadIdx.x == 0) (void)xb_add(&bar[XB_XCNT(b.x)], 1u);
    return b;
}
__device__ __forceinline__ void xcd_barrier_complete(unsigned* bar, unsigned x, unsigned& nloc, unsigned& nx) {
    const unsigned G = gridDim.x * gridDim.y * gridDim.z;
    unsigned sum, cnt, mine, sp = 0u;
    for (;;) {
        sum = 0u; cnt = 0u; mine = 0u;
#pragma unroll
        for (unsigned j = 0; j < 16; ++j) { const unsigned c = xb_ld(&bar[XB_XCNT(j)]); sum += c; cnt += (c > 0u) ? 1u : 0u; mine = (j == x) ? c : mine; }
        if (sum == G) break;
        __builtin_amdgcn_s_sleep(1);
        if ((++sp & 255u) == 0u) { if (xb_ld(&bar[XB_TMO])) break; if (sp > XB_SPIN_CAP) { atomicAdd(&bar[XB_TMO], 1u); break; } }
    }
    nloc = mine > 0u ? mine : 1u; nx = cnt > 0u ? cnt : 1u;
}
__device__ __forceinline__ void xcd_barrier(const XcdBarrier& b) {
    asm volatile("s_waitcnt vmcnt(0)" ::: "memory");
    __syncthreads();
    if (threadIdx.x == 0) {
        unsigned* bar = b.bar;
        __builtin_amdgcn_s_waitcnt(0);
        unsigned nloc = b.st[0], nx = b.st[1];
        if (nloc == 0u) { xcd_barrier_complete(bar, b.x, nloc, nx); b.st[0] = nloc; b.st[1] = nx; }
        const unsigned old = xb_add(&bar[XB_XSUB(b.x)], 1u);
        const unsigned gen = old / nloc;
        if (old + 1u == (gen + 1u) * nloc) {
            __builtin_amdgcn_fence(__ATOMIC_RELEASE, "agent");
            asm volatile("s_waitcnt vmcnt(0)" ::: "memory");
            const unsigned og = xb_add(&bar[XB_TOP], 1u);
            const unsigned tg = og / nx;
            if (og + 1u == (tg + 1u) * nx) xb_add(&bar[XB_TOPGEN], 1u);
            else XB_SPIN(xb_ld(&bar[XB_TOPGEN]) == tg, bar);
            __builtin_amdgcn_fence(__ATOMIC_ACQUIRE, "agent");
            xb_add(&bar[XB_XGEN(b.x)], 1u);
            asm volatile("s_waitcnt vmcnt(0)" ::: "memory");
        } else {
            XB_SPIN(xb_ld(&bar[XB_XGEN(b.x)]) == gen, bar);
            __builtin_amdgcn_fence(__ATOMIC_ACQUIRE, "agent");
            asm volatile("s_waitcnt vmcnt(0)" ::: "memory");
        }
    }
    __syncthreads();
}

__global__ void __launch_bounds__(512) fwd_kernel(Params p) {
    extern __shared__ __attribute__((aligned(16))) unsigned char shm[];
    cg::grid_group grid = cg::this_grid();
    LAS unsigned char* lds = (LAS unsigned char*)shm;
    unsigned char* ws = p.ws;
    const int G = gridDim.x, c = blockIdx.x;
    bf16_t* xb = (bf16_t*)(ws + A_XB); float* xres = (float*)(ws + A_XRES); float* ssqb = (float*)(ws + A_SSQ);
    volatile LAS unsigned* xst = (volatile LAS unsigned*)(lds + 131072);
    float* rsb = (float*)(shm + 131072 + 256);
    if (threadIdx.x == 0) { xst[0] = 0u; xst[1] = 0u; }
    __syncthreads();
    XcdBarrier xbar = xcd_barrier_post((unsigned*)(ws + A_BAR), xst);
    for (int ph = p.ph_lo; ph < p.ph_hi; ++ph) {
        int kind, l;
        if (ph == 0) { kind = 0; l = 0; }
        else if (ph == NPHASE - 1) { kind = 11; l = 0; }
        else { const int q = ph - 1, pr = q / 13, r = q - pr * 13;
            if (r < 5) { l = 2 * pr; kind = 1 + r; } else { l = 2 * pr + 1; const int rr = r - 5; kind = rr < 2 ? 6 + rr : (rr == 2 ? 12 : (rr < 6 ? 5 + rr : (rr == 6 ? 4 : 5))); } }
        const int lj = l >> 1;
        pg8::StaticOrder S;
#ifndef DUP_MASK
#define DUP_MASK 0
#endif
        for (int rep = 0; rep < 1 + ((DUP_MASK >> kind) & 1); ++rep) {
#ifndef KMASK
#define KMASK 0xFFF
#endif
#define KON(x) ((KMASK >> (x)) & 1)
        if (kind == 0) { if (KON(0)) phase_pre(p, shm); }
        else if (kind == 1 && KON(1)) {
            const bf16_t* Wt = (const bf16_t*)(ws + W_AIN) + (size_t)lj * 4096 * 1024; const float* ssq = ssqb + (size_t)(2 * l) * MT * 32;
            S.init(MP, 2048, G, c); load_rs(rsb, ssq, S);
            { pg8::Gemm g{xb, Wt, MP, 2048, 1024}; EpiGeluU E{(bf16_t*)(ws + R_U), rsb}; pg8::gemm_phase<EpiGeluU, false>(lds, g, S, E); }
            { pg8::Gemm g{xb, Wt + (size_t)2048 * 1024, MP, 2048, 1024}; EpiGeluVT E{(bf16_t*)(ws + R_VT), rsb, (float*)(ws + A_VSQ)}; pg8::gemm_phase<EpiGeluVT, true>(lds, g, S, E); }
            { EpiGeluS E{(bf16_t*)(ws + R_U), (float*)(ws + A_VS), ssq}; skinny_gemm(shm, xb + (size_t)MP * D, Wt, 1024, 128, E, G - 1 - c, G); }
        }
        else if (kind == 2) { if (KON(2)) phase_mix(p, lj, shm); }
        else if ((kind == 3 || kind == 10 || kind == 5) && KON(3)) {
            const bf16_t* A; const bf16_t* Wt; int K; int so;
            if (kind == 3) { A = (const bf16_t*)(ws + R_P); Wt = (const bf16_t*)(ws + W_AOUT) + (size_t)lj * 1024 * 2048; K = 2048; so = 2 * l + 1; }
            else if (kind == 10) { A = (const bf16_t*)(ws + R_OG); Wt = (const bf16_t*)(ws + W_BOUT) + (size_t)lj * 1024 * 1024; K = 1024; so = 2 * l + 1; }
            else { A = (const bf16_t*)(ws + R_ACT); Wt = (const bf16_t*)(ws + W_FOUT) + (size_t)l * 1024 * DFF; K = DFF; so = 2 * l + 2; }
            EpiRes E{xb, ssqb + (size_t)so * MT * 32};
            pg8::Gemm g{A, Wt, MP, 1024, K}; S.init(MP, 1024, G, c);
            pg8::gemm_phase<EpiRes, false>(lds, g, S, E);
            skinny_gemm(shm, A + (size_t)MP * K, Wt, K, 32, E, G - 1 - c, G);
        }
        else if (kind == 4 && KON(4)) {
            const bf16_t* Wt = (const bf16_t*)(ws + W_FIN) + (size_t)l * NFIN * 1024;
            EpiSwiglu E{(bf16_t*)(ws + R_ACT), ssqb + (size_t)(2 * l + 1) * MT * 32, rsb};
            pg8::Gemm g{xb, Wt, MP, NFIN, 1024}; S.init(MP, NFIN, G, c); load_rs(rsb, E.ssq, S);
            pg8::gemm_phase<EpiSwiglu, false>(lds, g, S, E);
            if (2 * c >= G) skinny_gemm(shm, xb + (size_t)MP * D, Wt, 1024, 176, E, G - 1 - c, G / 2);
        }
        else if (kind == 6 && KON(6)) {
            const bf16_t* Wt = (const bf16_t*)(ws + W_BIN) + (size_t)lj * 4096 * 1024;
            EpiProj E{(bf16_t*)(ws + R_PROJ), ssqb + (size_t)(2 * l) * MT * 32, rsb};
            pg8::Gemm g{xb, Wt, MP, 4096, 1024}; S.init(MP, 4096, G, c); load_rs(rsb, E.ssq, S);
            pg8::gemm_phase<EpiProj, false>(lds, g, S, E);
            skinny_gemm(shm, xb + (size_t)MP * D, Wt, 1024, 128, E, G - 1 - c, G);
            phase_ba(p, lj, l);
        }
        else if (kind == 7) { if (KON(7)) phase_conv(p, lj); }
        else if (kind == 12) { if (KON(8)) phase_prep(p, lj, shm); }
        else if (kind == 8) { if (KON(8)) phase_scan(p, lj, shm); }
        else if (kind == 9) { if (KON(9)) phase_onorm(p, lj, shm); }
        else if (kind == 11) { if (KON(11)) phase_final(p); }
        }
        if (ph + 1 < p.ph_hi) { if (p.ph_lo < 0) grid.sync();
            xcd_barrier(xbar); }
    }
}

extern "C" void kernel_launch(void* const* d_in, const int* in_sizes, int n_in, void* d_out, int out_size, void* d_ws, size_t ws_size, hipStream_t stream) {
    constexpr int LDS_BYTES = 131072 + 256 + 6144;
    static int grid_blocks = 0;
    if (grid_blocks == 0) {
        if (n_in != 20 || ws_size < WS_END) { fprintf(stderr, "kernel_launch: n_in %d ws %zu (need %zu)\n", n_in, ws_size, (size_t)WS_END); grid_blocks = -1; return; }
        int dev = 0, cus = 0, per_cu = 0;
        hipGetDevice(&dev);
        hipDeviceGetAttribute(&cus, hipDeviceAttributeMultiprocessorCount, dev);
        if (hipFuncSetAttribute((const void*)fwd_kernel, hipFuncAttributeMaxDynamicSharedMemorySize, LDS_BYTES) != hipSuccess) { fprintf(stderr, "kernel_launch: hipFuncSetAttribute failed\n"); grid_blocks = -1; return; }
        hipOccupancyMaxActiveBlocksPerMultiprocessor(&per_cu, (const void*)fwd_kernel, 512, LDS_BYTES);
        if (per_cu < 1) { fprintf(stderr, "kernel_launch: occupancy query says %d\n", per_cu); grid_blocks = -1; return; }
        grid_blocks = cus;
    }
    if (grid_blocks < 0) return;
    Params p{};
    for (int i = 0; i < 20; ++i) p.in[i] = (const float*)d_in[i];
    p.out = (float*)d_out; p.ws = (unsigned char*)d_ws;
    if (hipMemsetAsync((char*)d_ws + A_BAR, 0, 16384, stream) != hipSuccess) { fprintf(stderr, "kernel_launch: memset failed\n"); return; }
#if MULTI_LAUNCH
    for (int ph = 0; ph < NPHASE; ++ph) { p.ph_lo = ph; p.ph_hi = ph + 1; hipLaunchKernelGGL(fwd_kernel, dim3(grid_blocks), dim3(512), LDS_BYTES, stream, p); }
#else
    p.ph_lo = 0; p.ph_hi = NPHASE;
    void* args[] = {&p};
    hipError_t e = hipLaunchCooperativeKernel((const void*)fwd_kernel, dim3(grid_blocks), dim3(512), args, LDS_BYTES, stream);
    if (e != hipSuccess) fprintf(stderr, "cooperative launch failed: %s (grid %d)\n", hipGetErrorString(e), grid_blocks);
#endif
}
```
